# Optimizing an MI355X kernel written in HIP

```python
import jax, jax.numpy as jnp
from jax import lax
import numpy as np

D_MODEL = 2048
BATCH = 4
SEQ = 2048
DEPTH = 2

HEAD_DIM = 128
A_HEADS = 6
A_KV_HEADS = 2
A_ROPE_THETA = 10000.0
B_HEADS = 4
B_PATTERNS = ((128, 1), (512, 4), (2048, 16))
B_N_GROUPS = 3
C_HEADS = 6
C_Q_RANK = 512
C_KV_RANK = 512
C_NOPE_DIM = 128
C_ROPE_DIM = 64
C_V_DIM = 128
C_ROPE_THETA = 10000.0
PARTIAL_ROPE_DIM = HEAD_DIM // 4
PARTIAL_ROPE_THETA = 500000.0
GRID_W = 64
Q_BLOCK = 128
D_FF = 5632
CONV_W = 3
EPS = 1e-6

A_WIDTH = A_HEADS * HEAD_DIM
B_WIDTH = B_HEADS * HEAD_DIM
C_WIDTH = C_HEADS * C_V_DIM
MIX_WIDTH = A_WIDTH + B_WIDTH + C_WIDTH

A_Q_COLS = A_HEADS * HEAD_DIM
A_KV_COLS = A_KV_HEADS * HEAD_DIM
B_Q_COLS = B_N_GROUPS * B_HEADS * HEAD_DIM
B_KV_COLS = B_HEADS * HEAD_DIM
IN_SPLITS = (A_Q_COLS, A_KV_COLS, A_KV_COLS, B_Q_COLS, B_KV_COLS, B_KV_COLS, C_Q_RANK, C_KV_RANK, C_ROPE_DIM)
IN_WIDTH = A_Q_COLS + 2 * A_KV_COLS + B_Q_COLS + 2 * B_KV_COLS + C_Q_RANK + C_KV_RANK + C_ROPE_DIM

kernel_name = "hybrid_parallel_gqa_dilated_mla_convffn"


def rms_norm(x, g):
    xf = x.astype(jnp.float32)
    y = xf * lax.rsqrt(jnp.mean(xf * xf, axis=-1, keepdims=True) + EPS)
    return (y * g.astype(jnp.float32)).astype(x.dtype)


def rope_table(pos, dim, theta):
    inv = theta ** (-jnp.arange(0, dim, 2, dtype=jnp.float32) / dim)
    ang = pos.astype(jnp.float32)[:, None] * inv[None, :]
    return jnp.cos(ang), jnp.sin(ang)


def apply_rope(x, cs):
    cos, sin = cs
    cos = cos[:, None, :]
    sin = sin[:, None, :]
    xf = x.astype(jnp.float32)
    x1, x2 = jnp.split(xf, 2, axis=-1)
    return jnp.concatenate([x1 * cos - x2 * sin, x1 * sin + x2 * cos], axis=-1).astype(x.dtype)


def axial_rope(x, cs_row, cs_col):
    half = x.shape[-1] // 2
    return jnp.concatenate([apply_rope(x[..., :half], cs_row), apply_rope(x[..., half:], cs_col)], axis=-1)


def partial_rope(x, cs):
    return jnp.concatenate([apply_rope(x[..., :PARTIAL_ROPE_DIM], cs), x[..., PARTIAL_ROPE_DIM:]], axis=-1)


def dense_block_attention(q, k, v):
    b, s, hq, dk = q.shape
    hkv = k.shape[2]
    g = hq // hkv
    nb = s // Q_BLOCK
    scale = dk ** -0.5
    qb = q.reshape(b, nb, Q_BLOCK, hkv, g, dk).transpose(1, 0, 2, 3, 4, 5)

    def one_block(qblk):
        sc = jnp.einsum('bqhgd,bkhd->bhgqk', qblk, k).astype(jnp.float32) * scale
        p = jax.nn.softmax(sc, axis=-1).astype(v.dtype)
        return jnp.einsum('bhgqk,bkhd->bqhgd', p, v)

    o = lax.map(one_block, qb)
    return o.transpose(1, 0, 2, 3, 4, 5).reshape(b, s, hq, v.shape[-1])


def fold_stride(x, d):
    b, s, h, dh = x.shape
    return x.reshape(b, s // d, d, h, dh).transpose(0, 2, 1, 3, 4).reshape(b * d, s // d, h, dh)


def unfold_stride(x, b, d):
    l = x.shape[1]
    rest = x.shape[2:]
    perm = (0, 2, 1) + tuple(range(3, 3 + len(rest)))
    return x.reshape((b, d, l) + rest).transpose(perm).reshape((b, l * d) + rest)


def banded_attention(q, k, v, half):
    n, l, h, dh = q.shape
    blk = half
    nb = -(-l // blk)
    lp = nb * blk
    qp = jnp.pad(q, ((0, 0), (0, lp - l), (0, 0), (0, 0))).reshape(n, nb, blk, h, dh)

    def key_blocks(t):
        tp = jnp.pad(t, ((0, 0), (blk, lp - l + blk), (0, 0), (0, 0))).reshape(n, nb + 2, blk, h, dh)
        return jnp.concatenate([tp[:, :-2], tp[:, 1:-1], tp[:, 2:]], axis=2)

    kb = key_blocks(k)
    vb = key_blocks(v)
    qpos = jnp.arange(nb)[:, None] * blk + jnp.arange(blk)[None, :]
    kpos = jnp.arange(nb)[:, None] * blk - blk + jnp.arange(3 * blk)[None, :]
    rel = kpos[:, None, :] - qpos[:, :, None]
    valid = (jnp.abs(rel) <= half) & (kpos[:, None, :] >= 0) & (kpos[:, None, :] < l)
    sc = jnp.einsum('nbqhd,nbkhd->nbhqk', qp, kb).astype(jnp.float32) * (dh ** -0.5)
    sc = jnp.where(valid[None, :, None], sc, -jnp.inf)
    mx = jnp.max(sc, axis=-1, keepdims=True)
    e = jnp.exp(sc - mx)
    den = jnp.sum(e, axis=-1, keepdims=True)
    o = jnp.einsum('nbhqk,nbkhd->nbqhd', (e / den).astype(v.dtype), vb)
    lse = (mx + jnp.log(den))[..., 0]
    o = o.reshape(n, lp, h, dh)[:, :l]
    lse = lse.transpose(0, 1, 3, 2).reshape(n, lp, h)[:, :l]
    return o, lse


def dilated_mixture(q_groups, k, v):
    b = k.shape[0]
    outs = []
    lses = []
    for g, (window, dil) in enumerate(B_PATTERNS):
        half = window // (2 * dil)
        o, lse = banded_attention(fold_stride(q_groups[:, :, g], dil), fold_stride(k, dil),
                                  fold_stride(v, dil), half)
        outs.append(unfold_stride(o, b, dil))
        lses.append(unfold_stride(lse, b, dil))
    w = jax.nn.softmax(jnp.stack(lses, axis=0), axis=0)
    y = jnp.einsum('gbsh,gbshd->bshd', w, jnp.stack(outs, axis=0).astype(jnp.float32))
    return y.astype(k.dtype)


def conv_ffn(x, w_up, conv_w, conv_b, w_down):
    h = x @ w_up
    s = h.shape[1]
    hp = jnp.pad(h, ((0, 0), (1, 1), (0, 0)))
    h = hp[:, :s] * conv_w[0] + hp[:, 1:s + 1] * conv_w[1] + hp[:, 2:] * conv_w[2] + conv_b
    gate, up = jnp.split(h, 2, axis=-1)
    return (jax.nn.silu(gate) * up) @ w_down


def setup_inputs(seed: int = 0) -> dict:
    key = jax.random.key(seed)
    ks = jax.random.split(key, 20)
    f32 = jnp.float32

    def nrm(k, shape, scale):
        return jax.random.normal(k, shape, f32) * scale

    def gain(k, shape):
        return 1.0 + 0.02 * jax.random.normal(k, shape, f32)

    return {
        "x": jax.random.normal(ks[0], (BATCH, SEQ, D_MODEL), f32),
        "attn_norm": gain(ks[1], (DEPTH, D_MODEL)),
        "w_in": nrm(ks[2], (DEPTH, D_MODEL, IN_WIDTH), D_MODEL ** -0.5),
        "a_q_norm": gain(ks[3], (DEPTH, HEAD_DIM)),
        "a_k_norm": gain(ks[4], (DEPTH, HEAD_DIM)),
        "c_q_norm": gain(ks[5], (DEPTH, C_Q_RANK)),
        "c_kv_norm": gain(ks[6], (DEPTH, C_KV_RANK)),
        "w_uq": nrm(ks[7], (DEPTH, C_Q_RANK, C_HEADS * (C_NOPE_DIM + C_ROPE_DIM)), C_Q_RANK ** -0.5),
        "w_ukv": nrm(ks[8], (DEPTH, C_KV_RANK, C_HEADS * (C_NOPE_DIM + C_V_DIM)), C_KV_RANK ** -0.5),
        "out_norm": gain(ks[9], (DEPTH, MIX_WIDTH)),
        "w_out": nrm(ks[10], (DEPTH, MIX_WIDTH, D_MODEL), MIX_WIDTH ** -0.5),
        "ffn_norm": gain(ks[11], (DEPTH, D_MODEL)),
        "w_up": nrm(ks[12], (DEPTH, D_MODEL, 2 * D_FF), D_MODEL ** -0.5),
        "conv_w": nrm(ks[13], (DEPTH, CONV_W, 2 * D_FF), CONV_W ** -0.5),
        "conv_b": nrm(ks[14], (DEPTH, 2 * D_FF), 0.01),
        "w_down": nrm(ks[15], (DEPTH, D_FF, D_MODEL), D_FF ** -0.5),
        "final_norm": gain(ks[16], (D_MODEL,)),
    }


def reference(x, attn_norm, w_in, a_q_norm, a_k_norm, c_q_norm, c_kv_norm, w_uq, w_ukv, out_norm,
              w_out, ffn_norm, w_up, conv_w, conv_b, w_down, final_norm):
    b, s, _ = x.shape
    rows = s // GRID_W
    row_pos = jnp.repeat(jnp.arange(rows), GRID_W)
    col_pos = jnp.tile(jnp.arange(GRID_W), rows)
    t_pos = jnp.arange(s)
    cs_row = rope_table(row_pos, HEAD_DIM // 2, A_ROPE_THETA)
    cs_col = rope_table(col_pos, HEAD_DIM // 2, A_ROPE_THETA)
    cs_part = rope_table(t_pos, PARTIAL_ROPE_DIM, PARTIAL_ROPE_THETA)
    cs_mla = rope_table(t_pos, C_ROPE_DIM, C_ROPE_THETA)
    split_idx = np.cumsum(np.array(IN_SPLITS))[:-1].tolist()

    for l in range(DEPTH):
        hn = rms_norm(x, attn_norm[l])
        proj = hn @ w_in[l]
        aq, ak, av, bq, bk, bv, cq, ckv, ckr = jnp.split(proj, split_idx, axis=-1)

        aq = axial_rope(rms_norm(aq.reshape(b, s, A_HEADS, HEAD_DIM), a_q_norm[l]), cs_row, cs_col)
        ak = axial_rope(rms_norm(ak.reshape(b, s, A_KV_HEADS, HEAD_DIM), a_k_norm[l]), cs_row, cs_col)
        av = av.reshape(b, s, A_KV_HEADS, HEAD_DIM)
        ya = dense_block_attention(aq, ak, av).reshape(b, s, A_WIDTH)

        bq = partial_rope(bq.reshape(b, s, B_N_GROUPS * B_HEADS, HEAD_DIM), cs_part)
        bq = bq.reshape(b, s, B_N_GROUPS, B_HEADS, HEAD_DIM)
        bk = partial_rope(bk.reshape(b, s, B_HEADS, HEAD_DIM), cs_part)
        bv = bv.reshape(b, s, B_HEADS, HEAD_DIM)
        yb = dilated_mixture(bq, bk, bv).reshape(b, s, B_WIDTH)

        q = (rms_norm(cq, c_q_norm[l]) @ w_uq[l]).reshape(b, s, C_HEADS, C_NOPE_DIM + C_ROPE_DIM)
        q = jnp.concatenate([q[..., :C_NOPE_DIM], apply_rope(q[..., C_NOPE_DIM:], cs_mla)], axis=-1)
        kv = (rms_norm(ckv, c_kv_norm[l]) @ w_ukv[l]).reshape(b, s, C_HEADS, C_NOPE_DIM + C_V_DIM)
        k_nope = kv[..., :C_NOPE_DIM]
        cv = kv[..., C_NOPE_DIM:]
        k_rope = apply_rope(ckr[:, :, None, :], cs_mla)
        k = jnp.concatenate([k_nope, jnp.broadcast_to(k_rope, (b, s, C_HEADS, C_ROPE_DIM))], axis=-1)
        yc = dense_block_attention(q, k, cv).reshape(b, s, C_WIDTH)

        g_a, g_b, g_c = jnp.split(out_norm[l], [A_WIDTH, A_WIDTH + B_WIDTH])
        y = jnp.concatenate([rms_norm(ya, g_a), rms_norm(yb, g_b), rms_norm(yc, g_c)], axis=-1)
        x = x + y @ w_out[l]

        x = x + conv_ffn(rms_norm(x, ffn_norm[l]), w_up[l], conv_w[l], conv_b[l], w_down[l])

    return rms_norm(x, final_norm)
```

```cpp
#include <hip/hip_runtime.h>
#include <hip/hip_cooperative_groups.h>
#include <hip/hip_bf16.h>
#include <cstdio>
#include <cstdint>
#include <cmath>
namespace cg = cooperative_groups;
namespace pg8 {
#define PG8_LAS __attribute__((address_space(3)))
typedef unsigned short bf16_t;
typedef short bf16x8 __attribute__((ext_vector_type(8)));
typedef float f32x4 __attribute__((ext_vector_type(4)));
typedef unsigned u32x4 __attribute__((ext_vector_type(4)));
constexpr int BM = 256, BK = 64, HALF = 128, HTB = HALF * BK * 2  , STAGE_BYTES = 8 * HTB, NXCD = 8, WGM = 8;

__host__ __device__ __forceinline__ int lds_byte(int r, int c) { const int st = (r >> 4) * 2 + (c >> 5), rr = r & 15, cc = c & 31, ob = rr * 64 + cc * 2; return st * 1024 + (ob ^ (((ob >> 9) & 1) << 5)); }
__host__ __device__ __forceinline__ void stage_rc(int b, int& R, int& C) { const int st = b / 1024, sb = b % 1024, swz = sb ^ (((sb >> 9) & 1) << 5); R = (st >> 1) * 16 + swz / 64; C = (st & 1) * 32 + (swz % 64) / 2; }
__host__ __device__ __forceinline__ int perm32(int rho) { const int n = rho >> 4, i = rho & 15; return 8 * (i >> 2) + 4 * n + (i & 3); }

struct Unit { int pm, pn; };
struct Gemm { const bf16_t* A; const bf16_t* Bt; int M, N, K, lda; };

struct StaticOrder {
    int nM, nN, nwg, G, c;
    __host__ __device__ void init(int M, int N, int G_, int c_) { nM = M / BM; nN = N / BM; nwg = nM * nN; G = G_; c = c_; }
    __host__ __device__ bool next(int i, Unit& u) const {
        const long L = (long)i * G + c; if (L >= nwg) return false;
        int wgid = (int)L; { const int q = nwg / NXCD, r = nwg % NXCD, xcd = wgid % NXCD, off = wgid / NXCD; wgid = (xcd < r ? xcd * (q + 1) : r * (q + 1) + (xcd - r) * q) + off; }
        const int nig = WGM * nN, gid = wgid / nig, fm = gid * WGM, gsz = (nM - fm) < WGM ? (nM - fm) : WGM;
        u.pm = fm + ((wgid % nig) % gsz); u.pn = (wgid % nig) / gsz; return true;
    }
    __device__ __forceinline__ void a_ready(const Unit&) const {}
    __device__ __forceinline__ void done(const Unit&) const {}
};

__device__ __forceinline__ unsigned cvt_pk_bf16(float lo, float hi) { unsigned r; asm volatile("v_cvt_pk_bf16_f32 %0, %1, %2" : "=v"(r) : "v"(lo), "v"(hi)); return r; }

template <int MODE> struct EpiBf16G {
    static constexpr bool PERM = true, AFTER_DRAIN = false;
    bf16_t* O; int ldc; int ncols; bf16_t* O2; int ldc2;
    __device__ __forceinline__ void operator()(const f32x4 (&acc)[2][2][4][2], const Unit& u, int wr, int wc, int fr, int fq) const {
        const int row0 = u.pm * BM + wr * 64 + fr;
#pragma unroll
        for (int ai = 0; ai < 2; ++ai)
#pragma unroll
            for (int m = 0; m < 4; ++m) { const size_t row = (size_t)(row0 + ai * HALF + m * 16);
#pragma unroll
                for (int bj = 0; bj < 2; ++bj) {
                    const f32x4 v0 = acc[ai][bj][m][0], v1 = acc[ai][bj][m][1];
                    u32x4 w; w.x = cvt_pk_bf16(v0[0], v0[1]); w.y = cvt_pk_bf16(v0[2], v0[3]); w.z = cvt_pk_bf16(v1[0], v1[1]); w.w = cvt_pk_bf16(v1[2], v1[3]);
                    if (MODE == 0) { const int col = u.pn * BM + bj * HALF + wc * 32 + 8 * fq; if (col < ncols) *(u32x4*)(O + row * ldc + col) = w; }
                    else { if (bj == 0) *(u32x4*)(O + row * ldc + u.pn * 192 + wc * 32 + 8 * fq) = w; else *(u32x4*)(O2 + row * ldc2 + u.pn * 128 + wc * 32 + 8 * fq) = w; }
                } }
    }
};
struct EpiF32Res {
    static constexpr bool PERM = false, AFTER_DRAIN = false;
    const float* base; float* out; int ldc;
    __device__ __forceinline__ void operator()(const f32x4 (&acc)[2][2][4][2], const Unit& u, int wr, int wc, int fr, int fq) const {
        const int row0 = u.pm * BM + wr * 64 + fr, col0 = u.pn * BM + wc * 32 + 4 * fq;
#pragma unroll
        for (int ai = 0; ai < 2; ++ai)
#pragma unroll
            for (int m = 0; m < 4; ++m) { const size_t off = (size_t)(row0 + ai * HALF + m * 16) * ldc + col0;
#pragma unroll
                for (int bj = 0; bj < 2; ++bj)
#pragma unroll
                    for (int n = 0; n < 2; ++n) { const f32x4 b = *(const f32x4*)(base + off + bj * HALF + n * 16); *(f32x4*)(out + off + bj * HALF + n * 16) = b + acc[ai][bj][m][n]; } }
    }
};
template <class Epi, class Sched, bool ALIGN_EPI = false, bool SP2 = false>
__device__ __forceinline__ void gemm_phase(PG8_LAS unsigned char* lds, const Gemm g, const Sched& S, const Epi& E) {
    int tid_ = threadIdx.x; asm volatile("" : "+v"(tid_));
    const int tid = tid_, wid = __builtin_amdgcn_readfirstlane(tid >> 6), lane = tid & 63, wr = wid >> 2, wc = wid & 3, fr = lane & 15, fq = lane >> 4;
    const int K = g.K, nt = K / BK;
    unsigned voffA[2], voffB[2];
#pragma unroll
    for (int i = 0; i < 2; ++i) { int R, C; stage_rc(tid * 16 + i * 8192, R, C); const int Rb = Epi::PERM ? ((R & ~31) + perm32(R & 31)) : R;
        voffA[i] = (unsigned)(R * g.lda + C) * 2u; voffB[i] = (unsigned)(Rb * K + C) * 2u; }
    const size_t kstep = (size_t)(BK * 2);
    const size_t hstepA = (size_t)HALF * g.lda * 2, hstepB = (size_t)HALF * K * 2;
    const size_t tstepA = 2 * hstepA, tstepB = 2 * hstepB;
    const unsigned ldsw = (unsigned)wid * 1024u;
    const int aoff = lds_byte(wr * 64 + fr, fq * 8), boff = lds_byte(wc * 32 + fr, fq * 8);
#define PG8_SA(b, h) (((b) * 2 + (h)) * HTB)
#define PG8_SB(b, h) ((4 + (b) * 2 + (h)) * HTB)
#define PG8_STAGE(bufoff, gbase, voff) do { _Pragma("unroll") for (int _i = 0; _i < 2; ++_i) \
        __builtin_amdgcn_global_load_lds((const unsigned*)((const char*)(gbase) + (voff)[_i]), (PG8_LAS unsigned*)(lds + (bufoff) + ldsw + _i * 8192), 16, 0, 0); } while (0)
#define PG8_LDA(dst, b, h) do { _Pragma("unroll") for (int m = 0; m < 4; ++m) _Pragma("unroll") for (int k = 0; k < 2; ++k) dst[m][k] = *(const PG8_LAS bf16x8*)(lds + PG8_SA(b, h) + aoff + m * 2048 + k * 1024); } while (0)
#define PG8_LDB(dst, b, h) do { _Pragma("unroll") for (int n = 0; n < 2; ++n) _Pragma("unroll") for (int k = 0; k < 2; ++k) dst[n][k] = *(const PG8_LAS bf16x8*)(lds + PG8_SB(b, h) + boff + n * 2048 + k * 1024); } while (0)
#define PG8_MMA(ai, bj, At, Bt) do { __builtin_amdgcn_s_setprio(1); _Pragma("unroll") for (int m = 0; m < 4; ++m) _Pragma("unroll") for (int n = 0; n < 2; ++n) _Pragma("unroll") for (int k = 0; k < 2; ++k) \
        acc[ai][bj][m][n] = __builtin_amdgcn_mfma_f32_16x16x32_bf16(Bt[n][k], At[m][k], acc[ai][bj][m][n], 0, 0, 0); __builtin_amdgcn_s_setprio(0); } while (0)
#define PG8_WAIT_V(n) asm volatile("s_waitcnt vmcnt(" #n ")" ::: "memory")
#define PG8_WAIT_L(n) asm volatile("s_waitcnt lgkmcnt(" #n ")" ::: "memory")
#define PG8_BAR __builtin_amdgcn_s_barrier()
#define PG8_SCHED __builtin_amdgcn_sched_barrier(0)
    Unit cur, nxt; int ui = 0;
    if (!S.next(0, cur)) return;
    f32x4 acc[2][2][4][2];
#pragma unroll
    for (int a = 0; a < 2; ++a)
#pragma unroll
        for (int b = 0; b < 2; ++b)
#pragma unroll
            for (int m = 0; m < 4; ++m)
#pragma unroll
                for (int n = 0; n < 2; ++n) acc[a][b][m][n] = (f32x4){0.f, 0.f, 0.f, 0.f};
    bf16x8 At[4][2], B0[2][2], B1[2][2];
    const char* cA = (const char*)g.A + (size_t)cur.pm * tstepA; const char* cB = (const char*)g.Bt + (size_t)cur.pn * tstepB;
    S.a_ready(cur);
    if constexpr (SP2) {
        PG8_STAGE(PG8_SB(0, 0), cB, voffB); PG8_STAGE(PG8_SB(0, 1), cB + hstepB, voffB); PG8_STAGE(PG8_SA(0, 0), cA, voffA); PG8_STAGE(PG8_SA(0, 1), cA + hstepA, voffA);
        if (wr == 1) PG8_BAR;
        PG8_WAIT_V(2); PG8_BAR;
        PG8_STAGE(PG8_SB(1, 0), cB + kstep, voffB); PG8_STAGE(PG8_SA(1, 0), cA + kstep, voffA); PG8_STAGE(PG8_SB(1, 1), cB + hstepB + kstep, voffB);
        PG8_WAIT_V(6); PG8_BAR;
    } else {
        PG8_STAGE(PG8_SB(0, 0), cB, voffB); PG8_STAGE(PG8_SA(0, 0), cA, voffA); PG8_STAGE(PG8_SB(0, 1), cB + hstepB, voffB); PG8_STAGE(PG8_SA(0, 1), cA + hstepA, voffA);
        if (wr == 1) PG8_BAR;
        PG8_WAIT_V(4); PG8_BAR;
        PG8_STAGE(PG8_SB(1, 0), cB + kstep, voffB); PG8_STAGE(PG8_SA(1, 0), cA + kstep, voffA); PG8_STAGE(PG8_SB(1, 1), cB + hstepB + kstep, voffB);
        PG8_WAIT_V(6); PG8_BAR;
    }
    for (;;) {
        const bool has_next = S.next(ui + 1, nxt);
        const char* nA = has_next ? (const char*)g.A + (size_t)nxt.pm * tstepA : cA; const char* nB = has_next ? (const char*)g.Bt + (size_t)nxt.pn * tstepB : cB;
        for (int t = 0; t < nt; t += 2) {
            const bool last = (t == nt - 2);
            const char* a1 = cA + (size_t)(t + 1) * kstep;
            const char* a2 = last ? nA : cA + (size_t)(t + 2) * kstep; const char* b2 = last ? nB : cB + (size_t)(t + 2) * kstep;
            const char* a3 = a2 + kstep; const char* b3 = b2 + kstep;
            if (last && has_next) S.a_ready(nxt);
            if constexpr (SP2) {
            PG8_LDB(B0, 0, 0); PG8_LDB(B1, 0, 1); PG8_SCHED; PG8_LDA(At, 0, 0); PG8_STAGE(PG8_SA(1, 1), a1 + hstepA, voffA);
            PG8_WAIT_V(8); PG8_WAIT_L(0); PG8_BAR; PG8_MMA(0, 0, At, B0); PG8_MMA(0, 1, At, B1); PG8_BAR; PG8_SCHED;
            PG8_LDA(At, 0, 1); PG8_STAGE(PG8_SB(0, 0), b2, voffB); PG8_STAGE(PG8_SB(0, 1), b2 + hstepB, voffB); PG8_STAGE(PG8_SA(0, 0), a2, voffA);
            PG8_WAIT_V(8); PG8_WAIT_L(0); PG8_BAR; PG8_MMA(1, 0, At, B0); PG8_MMA(1, 1, At, B1); PG8_BAR; PG8_SCHED;
            PG8_LDB(B0, 1, 0); PG8_LDB(B1, 1, 1); PG8_SCHED; PG8_LDA(At, 1, 0); PG8_STAGE(PG8_SA(0, 1), a2 + hstepA, voffA);
            PG8_WAIT_V(8); PG8_WAIT_L(0); PG8_BAR; PG8_MMA(0, 0, At, B0); PG8_MMA(0, 1, At, B1); PG8_BAR; PG8_SCHED;
            PG8_LDA(At, 1, 1); PG8_STAGE(PG8_SB(1, 0), b3, voffB); PG8_STAGE(PG8_SB(1, 1), b3 + hstepB, voffB); PG8_STAGE(PG8_SA(1, 0), a3, voffA);
            PG8_WAIT_V(8); PG8_WAIT_L(0); PG8_BAR; PG8_MMA(1, 0, At, B0); PG8_MMA(1, 1, At, B1); PG8_BAR; PG8_SCHED;
            } else {
            PG8_LDB(B0, 0, 0); PG8_SCHED; PG8_LDA(At, 0, 0); PG8_STAGE(PG8_SA(1, 1), a1 + hstepA, voffA);
            PG8_WAIT_L(8); PG8_BAR; PG8_WAIT_L(0); PG8_MMA(0, 0, At, B0); PG8_BAR; PG8_SCHED;
            PG8_LDB(B1, 0, 1); PG8_STAGE(PG8_SB(0, 0), b2, voffB);
            PG8_BAR; PG8_WAIT_L(0); PG8_MMA(0, 1, At, B1); PG8_BAR;
            PG8_LDA(At, 0, 1); PG8_STAGE(PG8_SA(0, 0), a2, voffA);
            PG8_BAR; PG8_WAIT_L(0); PG8_MMA(1, 0, At, B0); PG8_BAR; PG8_SCHED;
            PG8_STAGE(PG8_SB(0, 1), b2 + hstepB, voffB);
            PG8_WAIT_V(6); PG8_BAR; PG8_MMA(1, 1, At, B1); PG8_BAR;
            PG8_LDB(B0, 1, 0); PG8_SCHED; PG8_LDA(At, 1, 0); PG8_STAGE(PG8_SA(0, 1), a2 + hstepA, voffA);
            PG8_WAIT_L(8); PG8_BAR; PG8_WAIT_L(0); PG8_MMA(0, 0, At, B0); PG8_BAR; PG8_SCHED;
            PG8_LDB(B1, 1, 1); PG8_STAGE(PG8_SB(1, 0), b3, voffB);
            PG8_BAR; PG8_WAIT_L(0); PG8_MMA(0, 1, At, B1); PG8_BAR;
            PG8_LDA(At, 1, 1); PG8_STAGE(PG8_SA(1, 0), a3, voffA);
            PG8_BAR; PG8_WAIT_L(0); PG8_MMA(1, 0, At, B0); PG8_BAR; PG8_SCHED;
            PG8_STAGE(PG8_SB(1, 1), b3 + hstepB, voffB);
            PG8_WAIT_V(6); PG8_BAR; PG8_MMA(1, 1, At, B1); PG8_BAR;
            }
        }
        if constexpr (ALIGN_EPI) { if (wr == 0) PG8_BAR; }
        if constexpr (!Epi::AFTER_DRAIN) { E(acc, cur, wr, wc, fr, fq); S.done(cur); }
        if (!has_next) break;
#pragma unroll
        for (int a = 0; a < 2; ++a)
#pragma unroll
            for (int b = 0; b < 2; ++b)
#pragma unroll
                for (int m = 0; m < 4; ++m)
#pragma unroll
                    for (int n = 0; n < 2; ++n) acc[a][b][m][n] = (f32x4){0.f, 0.f, 0.f, 0.f};
        cur = nxt; cA = nA; cB = nB; ++ui;
        if constexpr (ALIGN_EPI) { if (wr == 1) PG8_BAR; }
    }
    PG8_WAIT_V(0);
    if constexpr (!ALIGN_EPI) { if (wr == 0) PG8_BAR; }
    PG8_BAR;
    if constexpr (Epi::AFTER_DRAIN) { E.fused(acc, cur, wr, wc, fr, fq, lds, wid, lane); S.done(cur); }
#undef PG8_SA
#undef PG8_SB
#undef PG8_STAGE
#undef PG8_LDA
#undef PG8_LDB
#undef PG8_MMA
#undef PG8_WAIT_V
#undef PG8_WAIT_L
#undef PG8_BAR
#undef PG8_SCHED
}
}
namespace att {
using bf16 = unsigned short;
using bf16x8 = __attribute__((ext_vector_type(8))) short;
using s16x4  = __attribute__((ext_vector_type(4))) short;
using f32x16 = __attribute__((ext_vector_type(16))) float;
using u32x4  = __attribute__((ext_vector_type(4))) unsigned;
constexpr int NW = 8, QBLK = 32, KVBLK = 64, DV = 128;
constexpr float THR = 8.f;
#define SBAR() __builtin_amdgcn_sched_barrier(0)
__device__ __forceinline__ int crow(int r, int hi) { return (r & 3) + 8 * (r >> 2) + 4 * hi; }
__device__ __forceinline__ unsigned cvtpk(float lo, float hi) { unsigned r; asm volatile("v_cvt_pk_bf16_f32 %0, %1, %2" : "=v"(r) : "v"(lo), "v"(hi)); return r; }
__device__ __forceinline__ bf16x8 ld8(const bf16* p) { return *reinterpret_cast<const bf16x8*>(p); }

__device__ __forceinline__ void partialSM(f32x16& p0, f32x16& p1, float& m_reg, float& mn, float& alpha, const float C, const float THRS) {
  float pmax = p0[0];
#pragma unroll
  for (int r = 1; r < 16; ++r) pmax = fmaxf(pmax, p0[r]);
#pragma unroll
  for (int r = 0; r < 16; ++r) pmax = fmaxf(pmax, p1[r]);
  { auto rr = __builtin_amdgcn_permlane32_swap(__float_as_uint(pmax), __float_as_uint(pmax), false, false);
    pmax = fmaxf(__uint_as_float(rr[0]), __uint_as_float(rr[1])); }
  if (__builtin_expect(__all(pmax - m_reg <= THRS), 1)) { mn = m_reg; alpha = 1.f; }
  else { mn = fmaxf(m_reg, pmax); alpha = __builtin_amdgcn_exp2f((m_reg - mn) * C); m_reg = mn; }
  float mnC = -mn * C;
#pragma unroll
  for (int r = 0; r < 16; ++r) p0[r] = fmaf(p0[r], C, mnC);
#pragma unroll
  for (int r = 0; r < 16; ++r) p1[r] = fmaf(p1[r], C, mnC);
#pragma unroll
  for (int r = 0; r < 16; ++r) p0[r] = __builtin_amdgcn_exp2f(p0[r]);
}
#define PK4(P, BASE, OUT) do { unsigned a0 = cvtpk(P[BASE + 0], P[BASE + 1]), a1 = cvtpk(P[BASE + 2], P[BASE + 3]);   \
    unsigned b0 = cvtpk(P[BASE + 4], P[BASE + 5]), b1 = cvtpk(P[BASE + 6], P[BASE + 7]);                              \
    auto r0 = __builtin_amdgcn_permlane32_swap(a0, b0, false, false); auto r1 = __builtin_amdgcn_permlane32_swap(a1, b1, false, false); \
    u32x4 w = {r0[0], r1[0], r0[1], r1[1]}; OUT = *reinterpret_cast<bf16x8*>(&w); } while (0)
__device__ __forceinline__ void finishSM(f32x16& p0, f32x16& p1, float alpha, float& l_reg, bf16x8& pa0, bf16x8& pa1, bf16x8& pa2, bf16x8& pa3) {
#pragma unroll
  for (int r = 0; r < 16; ++r) p1[r] = __builtin_amdgcn_exp2f(p1[r]);
  float ps = 0;
#pragma unroll
  for (int r = 0; r < 16; ++r) ps += p0[r];
#pragma unroll
  for (int r = 0; r < 16; ++r) ps += p1[r];
  { auto rr = __builtin_amdgcn_permlane32_swap(__float_as_uint(ps), __float_as_uint(ps), false, false);
    ps = __uint_as_float(rr[0]) + __uint_as_float(rr[1]); }
  l_reg = l_reg * alpha + ps;
  PK4(p0, 0, pa0); PK4(p0, 8, pa1); PK4(p1, 0, pa2); PK4(p1, 8, pa3);
}
template <int DK> __device__ __forceinline__ int kswz(int row, int colB) { return row * (DK * 2) + (colB ^ ((row & 7) << 4)); }
template <int DK> __device__ __forceinline__ void qkt(f32x16& p0, f32x16& p1, const char* Ks, const bf16x8* qr, int r32, int hi) {
  p0 = f32x16{}; p1 = f32x16{};
#pragma unroll
  for (int d0 = 0; d0 < DK / 16; ++d0) { int cb = (d0 * 16 + hi * 8) * 2;
    bf16x8 b0 = *reinterpret_cast<const bf16x8*>(Ks + kswz<DK>(r32, cb));
    bf16x8 b1 = *reinterpret_cast<const bf16x8*>(Ks + kswz<DK>(32 + r32, cb));
    p0 = __builtin_amdgcn_mfma_f32_32x32x16_bf16(b0, qr[d0], p0, 0, 0, 0);
    p1 = __builtin_amdgcn_mfma_f32_32x32x16_bf16(b1, qr[d0], p1, 0, 0, 0); }
}
__device__ __forceinline__ int v_st(int k, int c) { const int kk = (k & ~0xC) | ((k & 4) << 1) | ((k & 8) >> 1); return ((kk >> 3) * 4 + (c >> 5)) * 512 + ((kk & 7) * 32 + (c & 31)) * 2; }
__device__ __forceinline__ int v_rd_base(int lane) { return ((lane & 3) << 3) | (((lane >> 2) & 3) << 6) | (((lane >> 4) & 1) << 5) | (((lane >> 5) & 1) << 8); }
constexpr int v_rd_off(int d0, int ks, int half) { return d0 * 512 + ks * 4096 + half * 2048; }
template <int OFF> __device__ __forceinline__ s16x4 tr_read(int vb) {
  s16x4 r; asm volatile("ds_read_b64_tr_b16 %0, %1 offset:%2" : "=&v"(r) : "v"(vb), "i"(OFF) : "memory"); return r;
}
#define PKV(L, H) (bf16x8){L[0], L[1], L[2], L[3], H[0], H[1], H[2], H[3]}
template <int D0> __device__ __forceinline__ void pv_one(f32x16& od, int vb, bf16x8 pa0, bf16x8 pa1, bf16x8 pa2, bf16x8 pa3) {
  const s16x4 l0 = tr_read<v_rd_off(D0, 0, 0)>(vb), h0 = tr_read<v_rd_off(D0, 0, 1)>(vb), l1 = tr_read<v_rd_off(D0, 1, 0)>(vb), h1 = tr_read<v_rd_off(D0, 1, 1)>(vb);
  const s16x4 l2 = tr_read<v_rd_off(D0, 2, 0)>(vb), h2 = tr_read<v_rd_off(D0, 2, 1)>(vb), l3 = tr_read<v_rd_off(D0, 3, 0)>(vb), h3 = tr_read<v_rd_off(D0, 3, 1)>(vb);
  asm volatile("s_waitcnt lgkmcnt(0)" ::: "memory"); SBAR();
  od = __builtin_amdgcn_mfma_f32_32x32x16_bf16(pa0, PKV(l0, h0), od, 0, 0, 0);
  od = __builtin_amdgcn_mfma_f32_32x32x16_bf16(pa1, PKV(l1, h1), od, 0, 0, 0);
  od = __builtin_amdgcn_mfma_f32_32x32x16_bf16(pa2, PKV(l2, h2), od, 0, 0, 0);
  od = __builtin_amdgcn_mfma_f32_32x32x16_bf16(pa3, PKV(l3, h3), od, 0, 0, 0);
}
__device__ __forceinline__ void pv_d0(f32x16* o, int vb, bf16x8 pa0, bf16x8 pa1, bf16x8 pa2, bf16x8 pa3) {
  pv_one<0>(o[0], vb, pa0, pa1, pa2, pa3); pv_one<1>(o[1], vb, pa0, pa1, pa2, pa3); pv_one<2>(o[2], vb, pa0, pa1, pa2, pa3); pv_one<3>(o[3], vb, pa0, pa1, pa2, pa3);
}

template <int DK, int ldq, int ldk, int ldv, int ldo>
__device__ __forceinline__ void attn_dense_unit(const bf16* __restrict__ Qb, const bf16* __restrict__ Kh, const bf16* __restrict__ Vh,
                                                float* __restrict__ Ob, const float scale, char* lds, const int seqr) {
  constexpr int SHM_V = KVBLK * DV * 2, SHM_K = KVBLK * DK * 2, NQ = DK / 16, NKC = DK / 64;
  const float C = scale * 1.4426950408889634f, THRS = THR / scale;
  int tid_ = threadIdx.x; asm volatile("" : "+v"(tid_));
  const int tid = tid_, wid = tid >> 6, lane = tid & 63, r32 = lane & 31, hi = lane >> 5;
  char* V_lds = lds; char* K_lds = lds + 2 * SHM_V;
  float* ws = (float*)(lds + 2 * SHM_V + 2 * SHM_K) + wid * 64; float* li_l = ws; float* al_l = ws + 32;
  float m_reg = -1e30f, l_reg = 0; f32x16 o[4] = {}; bf16x8 qr[NQ];
  const bf16* Qw = Qb + (long)(wid * QBLK + r32) * ldq + hi * 8;
#pragma unroll
  for (int d0 = 0; d0 < NQ; ++d0) qr[d0] = ld8(Qw + d0 * 16);
  const int sr = tid >> 4, sc = (tid & 15) * 8, vst0 = v_st(sr, sc), vst1 = v_st(32 + sr, sc);
  int krow[NKC], kcol[NKC];
#pragma unroll
  for (int i = 0; i < NKC; ++i) { const int c = tid + 512 * i; krow[i] = c / (DK / 8); kcol[i] = (c % (DK / 8)) * 8; }
  const int vb0 = (int)(uintptr_t)V_lds + v_rd_base(lane);
  bf16x8 vs0, vs1, ks[NKC];
#define SLOAD(k0) do { vs0 = ld8(&Vh[(long)((k0) + sr) * ldv + sc]); vs1 = ld8(&Vh[(long)((k0) + 32 + sr) * ldv + sc]); \
    _Pragma("unroll") for (int i_ = 0; i_ < NKC; ++i_) ks[i_] = ld8(&Kh[(long)((k0) + krow[i_]) * ldk + kcol[i_]]); } while (0)
#define SWRITE(b) do { *(bf16x8*)(V_lds + (b) * SHM_V + vst0) = vs0; *(bf16x8*)(V_lds + (b) * SHM_V + vst1) = vs1; \
    _Pragma("unroll") for (int i_ = 0; i_ < NKC; ++i_) *(bf16x8*)(K_lds + (b) * SHM_K + kswz<DK>(krow[i_], kcol[i_] * 2)) = ks[i_]; } while (0)
  const int NT = seqr / KVBLK;
  SLOAD(0); SWRITE(0); __syncthreads();
  for (int j = 0; j < NT; ++j) {
    const int cb = j & 1;
    if (j + 1 < NT) SLOAD((j + 1) * KVBLK);
    SBAR();
    f32x16 p0, p1; float mn, al; bf16x8 pa0, pa1, pa2, pa3;
    qkt<DK>(p0, p1, K_lds + cb * SHM_K, qr, r32, hi);
    partialSM(p0, p1, m_reg, mn, al, C, THRS);
    if (__any(al < 1.f)) { if (hi == 0) al_l[r32] = al; asm volatile("s_waitcnt lgkmcnt(0)" ::: "memory");
#pragma unroll
      for (int d = 0; d < 4; ++d)
#pragma unroll
        for (int r = 0; r < 16; ++r) o[d][r] *= al_l[crow(r, hi)]; }
    finishSM(p0, p1, al, l_reg, pa0, pa1, pa2, pa3); SBAR();
    pv_d0(o, vb0 + cb * SHM_V, pa0, pa1, pa2, pa3);
    SBAR();
    if (j + 1 < NT) SWRITE(cb ^ 1);
    __syncthreads();
  }
  if (hi == 0) li_l[r32] = l_reg; asm volatile("s_waitcnt lgkmcnt(0)" ::: "memory");
  float rli[16];
#pragma unroll
  for (int r = 0; r < 16; ++r) rli[r] = __builtin_amdgcn_rcpf(li_l[crow(r, hi)]);
  float* Ow = Ob + (long)(wid * QBLK) * ldo;
#pragma unroll
  for (int r = 0; r < 16; ++r) { int orow = crow(r, hi);
#pragma unroll
    for (int d0 = 0; d0 < 4; ++d0) Ow[(long)orow * ldo + d0 * 32 + r32] = o[d0][r] * rli[r]; }
  __syncthreads();
#undef SLOAD
#undef SWRITE
}

__device__ __forceinline__ void banded_wave_unit(const bf16* __restrict__ Q, long qs, const bf16* __restrict__ K, long ks, const bf16* __restrict__ V, long vs,
                                                 int i0, int L, float* __restrict__ O, long os, float* __restrict__ LSE, long ls, char* wlds) {
  constexpr float SCALE = 0.088388347648318440f, C = SCALE * 1.4426950408889634f;
  int tid_ = threadIdx.x; asm volatile("" : "+v"(tid_));
  const int lane = tid_ & 63, r32 = lane & 31, hi = lane >> 5;
  float* ex = (float*)(wlds + 8192);
  const int vb = (int)(uintptr_t)wlds + v_rd_base(lane);
  bf16x8 qr[8];
  { const bf16* Qw = Q + (long)(i0 + r32) * qs + hi * 8;
#pragma unroll
    for (int d0 = 0; d0 < 8; ++d0) qr[d0] = ld8(Qw + d0 * 16); }
  float m_reg = -1e30f, l_reg = 0.f; f32x16 o[4] = {};
  for (int tt = -2; tt <= 2; ++tt) {
    const int j0 = i0 + 32 * tt;
    if (j0 < 0 || j0 >= L) continue;
    bf16x8 vr[8], kf[8];
#pragma unroll
    for (int i = 0; i < 8; ++i) { const int idx = lane + 64 * i; vr[i] = ld8(V + (long)(j0 + (idx >> 4)) * vs + (idx & 15) * 8); }
    { const bf16* Kw = K + (long)(j0 + r32) * ks + hi * 8;
#pragma unroll
      for (int d0 = 0; d0 < 8; ++d0) kf[d0] = ld8(Kw + d0 * 16); }
    f32x16 p = f32x16{};
#pragma unroll
    for (int d0 = 0; d0 < 8; ++d0) p = __builtin_amdgcn_mfma_f32_32x32x16_bf16(kf[d0], qr[d0], p, 0, 0, 0);
    if (tt == -2) {
#pragma unroll
      for (int r = 0; r < 16; ++r) if (crow(r, hi) < r32) p[r] = -INFINITY; }
    if (tt == 2) {
#pragma unroll
      for (int r = 0; r < 16; ++r) if (crow(r, hi) > r32) p[r] = -INFINITY; }
    float pmax = p[0];
#pragma unroll
    for (int r = 1; r < 16; ++r) pmax = fmaxf(pmax, p[r]);
    { auto rr = __builtin_amdgcn_permlane32_swap(__float_as_uint(pmax), __float_as_uint(pmax), false, false);
      pmax = fmaxf(__uint_as_float(rr[0]), __uint_as_float(rr[1])); }
    const float mn = fmaxf(m_reg, pmax), alpha = __builtin_amdgcn_exp2f((m_reg - mn) * C); m_reg = mn;
    const float mnC = -mn * C; float ps = 0.f;
#pragma unroll
    for (int r = 0; r < 16; ++r) { p[r] = __builtin_amdgcn_exp2f(fmaf(p[r], C, mnC)); ps += p[r]; }
    { auto rr = __builtin_amdgcn_permlane32_swap(__float_as_uint(ps), __float_as_uint(ps), false, false);
      ps = __uint_as_float(rr[0]) + __uint_as_float(rr[1]); }
    l_reg = l_reg * alpha + ps;
    bf16x8 pa0, pa1; PK4(p, 0, pa0); PK4(p, 8, pa1);
    if (hi == 0) ex[r32] = alpha;
#pragma unroll
    for (int i = 0; i < 8; ++i) { const int idx = lane + 64 * i; *(bf16x8*)(wlds + v_st(idx >> 4, (idx & 15) * 8)) = vr[i]; }
    asm volatile("s_waitcnt lgkmcnt(0)" ::: "memory"); SBAR();
#pragma unroll
    for (int d = 0; d < 4; ++d)
#pragma unroll
      for (int r = 0; r < 16; ++r) o[d][r] *= ex[crow(r, hi)];
#define PV2(D0) do { const s16x4 l0 = tr_read<v_rd_off(D0, 0, 0)>(vb), h0 = tr_read<v_rd_off(D0, 0, 1)>(vb), l1 = tr_read<v_rd_off(D0, 1, 0)>(vb), h1 = tr_read<v_rd_off(D0, 1, 1)>(vb); \
      asm volatile("s_waitcnt lgkmcnt(0)" ::: "memory"); SBAR(); \
      o[D0] = __builtin_amdgcn_mfma_f32_32x32x16_bf16(pa0, PKV(l0, h0), o[D0], 0, 0, 0); \
      o[D0] = __builtin_amdgcn_mfma_f32_32x32x16_bf16(pa1, PKV(l1, h1), o[D0], 0, 0, 0); } while (0)
    PV2(0); PV2(1); PV2(2); PV2(3);
#undef PV2
    asm volatile("s_waitcnt lgkmcnt(0)" ::: "memory"); SBAR();
  }
  if (hi == 0) { ex[32 + r32] = l_reg; LSE[(long)(i0 + r32) * ls] = m_reg * SCALE + __logf(l_reg); }
  asm volatile("s_waitcnt lgkmcnt(0)" ::: "memory"); SBAR();
  float rli[16];
#pragma unroll
  for (int r = 0; r < 16; ++r) rli[r] = __builtin_amdgcn_rcpf(ex[32 + crow(r, hi)]);
#pragma unroll
  for (int r = 0; r < 16; ++r) { const int orow = crow(r, hi);
#pragma unroll
    for (int d0 = 0; d0 < 4; ++d0) O[(long)(i0 + orow) * os + d0 * 32 + r32] = o[d0][r] * rli[r]; }
  asm volatile("s_waitcnt lgkmcnt(0)" ::: "memory"); SBAR();
}
#undef PK4
#undef PKV
#undef SBAR
}
#define LAS __attribute__((address_space(3)))
typedef unsigned short bf16;
typedef unsigned v4u __attribute__((ext_vector_type(4)));
typedef unsigned v2u __attribute__((ext_vector_type(2)));
typedef float f32x4 __attribute__((ext_vector_type(4)));

constexpr int NB = 4, SEQ = 2048, T = NB * SEQ, DM = 2048, DEPTH = 2;
constexpr int NIN = 4928, NINP = 5120, NUQ = 1152, NUQP = 1280, NUKV = 1536, DFF = 5632, NUP = 2 * DFF, CQR = 512;
constexpr int AQ_OFF = 0, AK_OFF = 768, AV_OFF = 1024, BQ_OFF = 1280, BK_OFF = 2816, BV_OFF = 3328, CQ_OFF = 3840, CKV_OFF = 4352, CKR_OFF = 4864;
constexpr float EPS = 1e-6f;
constexpr int NWAVES = 8, NTHR = 512;
constexpr int LDS_BYTES = 147456;

constexpr size_t MiB = 1u << 20;
constexpr size_t SZ_WIN = (size_t)NINP * DM * 2, SZ_WUQ = (size_t)NUQP * CQR * 2, SZ_WUKV = (size_t)NUKV * CQR * 2, SZ_WOUT = (size_t)DM * DM * 2, SZ_WUP = (size_t)NUP * DM * 2, SZ_WDN = (size_t)DM * DFF * 2;
constexpr size_t WL_IN = 0, WL_UQ = WL_IN + SZ_WIN, WL_UKV = WL_UQ + SZ_WUQ, WL_OUT = WL_UKV + SZ_WUKV, WL_UP = WL_OUT + SZ_WOUT, WL_DN = WL_UP + SZ_WUP, WL_SIZE = WL_DN + SZ_WDN;
constexpr size_t WS_W = 1 * MiB;
constexpr size_t WS_XN = WS_W + 2 * WL_SIZE;
constexpr size_t WS_X = WS_XN + (size_t)T * DM * 2;
constexpr size_t WS_R1 = WS_X + (size_t)T * DM * 4;
constexpr size_t WS_PROJ = WS_R1;
constexpr size_t WS_QC = WS_PROJ + (size_t)T * NINP * 2;
constexpr size_t WS_KC = WS_QC + (size_t)T * NUQ * 2;
constexpr size_t WS_VC = WS_KC + (size_t)T * NUQ * 2;
constexpr size_t WS_OB = WS_VC + (size_t)T * 768 * 2;
constexpr size_t WS_LSE = WS_OB + (size_t)3 * T * 512 * 4;
constexpr size_t WS_R1_END = WS_LSE + (size_t)3 * T * 4 * 4;
constexpr size_t WS_H = WS_R1;
constexpr size_t WS_H_END = WS_H + (size_t)T * NUP * 2;
constexpr size_t WS_R2 = (WS_R1_END > WS_H_END ? WS_R1_END : WS_H_END);
constexpr size_t WS_Y = WS_R2;
constexpr size_t WS_YN = WS_Y + (size_t)T * DM * 4;
constexpr size_t WS_ACT = WS_R2;
constexpr size_t WS_END = WS_YN + (size_t)T * DM * 2;
static_assert((size_t)T * DFF * 2 <= (size_t)T * DM * 6, "ACT fits over Y|YN");
static_assert(WS_W % 256 == 0 && WL_SIZE % 256 == 0 && WS_R2 % 256 == 0, "alignment");

struct Args {
    const float *x, *attn_norm, *w_in, *a_q_norm, *a_k_norm, *c_q_norm, *c_kv_norm, *w_uq, *w_ukv, *out_norm, *w_out, *ffn_norm, *w_up, *conv_w, *conv_b, *w_down, *final_norm;
    float* out; unsigned char* ws; int ph_lo, ph_hi;
};

__device__ __forceinline__ unsigned f2bf(float f) { unsigned u = __builtin_bit_cast(unsigned, f); return (u + 0x7fffu + ((u >> 16) & 1u)) >> 16; }
__device__ __forceinline__ unsigned pk2(float lo, float hi) { return f2bf(lo) | (f2bf(hi) << 16); }
__device__ __forceinline__ float bf2f(unsigned short h) { return __builtin_bit_cast(float, (unsigned)h << 16); }
__device__ __forceinline__ float bflo(unsigned w) { return __builtin_bit_cast(float, w << 16); }
__device__ __forceinline__ float bfhi(unsigned w) { return __builtin_bit_cast(float, w & 0xffff0000u); }
__device__ __forceinline__ float wave_sum(float v) {
#pragma unroll
    for (int o = 1; o < 64; o <<= 1) v += __shfl_xor(v, o);
    return v;
}

__device__ __forceinline__ void p0_transpose_item(const float* W, int K, int N, bf16* WT, float* scr, int item, int lane) {
    const int nblk = N / 32, kb = item / nblk, nb = item % nblk, k0 = 64 * kb, n0 = 32 * nb;
#pragma unroll 8
    for (int i = 0; i < 32; ++i) { const int kk = 2 * i + (lane >> 5); scr[kk * 33 + (lane & 31)] = W[(size_t)(k0 + kk) * N + n0 + (lane & 31)]; }
    asm volatile("s_waitcnt lgkmcnt(0)" ::: "memory");
    const int c = lane & 7;
#pragma unroll
    for (int j = 0; j < 4; ++j) { const int n = (lane >> 3) + 8 * j; const float* s = scr + (8 * c) * 33 + n;
        v4u o; o.x = pk2(s[0 * 33], s[1 * 33]); o.y = pk2(s[2 * 33], s[3 * 33]); o.z = pk2(s[4 * 33], s[5 * 33]); o.w = pk2(s[6 * 33], s[7 * 33]);
        *(v4u*)(WT + (size_t)(n0 + n) * K + k0 + 8 * c) = o; }
    asm volatile("s_waitcnt lgkmcnt(0)" ::: "memory");
}
__device__ __forceinline__ void rms_row_bf16(const float* xrow, const float* g, bf16* orow, int lane) {
    const f32x4* xr = (const f32x4*)xrow + lane; const f32x4* gr = (const f32x4*)g + lane;
    f32x4 v[8]; float s = 0.f;
#pragma unroll
    for (int j = 0; j < 8; ++j) { v[j] = xr[64 * j]; s += (v[j].x * v[j].x + v[j].y * v[j].y) + (v[j].z * v[j].z + v[j].w * v[j].w); }
    const float rstd = 1.f / sqrtf(wave_sum(s) * (1.f / DM) + EPS);
    v2u* o8 = (v2u*)orow + lane;
#pragma unroll
    for (int j = 0; j < 8; ++j) { const f32x4 gg = gr[64 * j]; v2u w; w.x = pk2(v[j].x * rstd * gg.x, v[j].y * rstd * gg.y); w.y = pk2(v[j].z * rstd * gg.z, v[j].w * rstd * gg.w); o8[64 * j] = w; }
}
__device__ __forceinline__ void rms_row_f32(const float* xrow, const float* g, float* orow, int lane) {
    const f32x4* xr = (const f32x4*)xrow + lane; const f32x4* gr = (const f32x4*)g + lane;
    f32x4 v[8]; float s = 0.f;
#pragma unroll
    for (int j = 0; j < 8; ++j) { v[j] = xr[64 * j]; s += (v[j].x * v[j].x + v[j].y * v[j].y) + (v[j].z * v[j].z + v[j].w * v[j].w); }
    const float rstd = 1.f / sqrtf(wave_sum(s) * (1.f / DM) + EPS);
    f32x4* o = (f32x4*)orow + lane;
#pragma unroll
    for (int j = 0; j < 8; ++j) { const f32x4 gg = gr[64 * j]; o[64 * j] = v[j] * rstd * gg; }
}
__device__ __forceinline__ float inv_freq(float theta, int j2, int dim) { return powf(theta, -(float)j2 / (float)dim); }

__device__ __forceinline__ void prep_row(bf16* P, bf16* KCrow, int s, const float* aqn, const float* akn, const float* cqn, const float* ckvn, int lane) {
    { const int j = lane & 31, base = (lane < 32) ? 0 : 64, p1 = base + j, p2 = base + j + 32;
      const float pos = (lane < 32) ? (float)(s / 64) : (float)(s % 64);
      const float ang = pos * inv_freq(10000.f, 2 * j, 64); const float cs = cosf(ang), sn = sinf(ang);
#pragma unroll
      for (int hh = 0; hh < 8; ++hh) { bf16* hp = P + AQ_OFF + hh * 128; const float* g = (hh < 6) ? aqn : akn;
          const float x1 = bf2f(hp[p1]), x2 = bf2f(hp[p2]);
          const float rstd = 1.f / sqrtf(wave_sum(x1 * x1 + x2 * x2) * (1.f / 128.f) + EPS);
          const float y1 = x1 * rstd * g[p1], y2 = x2 * rstd * g[p2];
          hp[p1] = (bf16)f2bf(y1 * cs - y2 * sn); hp[p2] = (bf16)f2bf(y1 * sn + y2 * cs); } }
#pragma unroll
    for (int i = 0; i < 4; ++i) { const int idx = lane + 64 * i, hh = idx >> 4, j = idx & 15; bf16* hp = P + BQ_OFF + hh * 128;
        const float ang = (float)s * inv_freq(500000.f, 2 * j, 32); const float cs = cosf(ang), sn = sinf(ang);
        const float x1 = bf2f(hp[j]), x2 = bf2f(hp[j + 16]);
        hp[j] = (bf16)f2bf(x1 * cs - x2 * sn); hp[j + 16] = (bf16)f2bf(x1 * sn + x2 * cs); }
#pragma unroll
    for (int w = 0; w < 2; ++w) { bf16* lp = P + (w == 0 ? CQ_OFF : CKV_OFF) + lane * 8; const float* g = (w == 0 ? cqn : ckvn) + lane * 8;
        const v4u raw = *(const v4u*)lp; float f[8] = {bflo(raw.x), bfhi(raw.x), bflo(raw.y), bfhi(raw.y), bflo(raw.z), bfhi(raw.z), bflo(raw.w), bfhi(raw.w)};
        float ss = 0.f;
#pragma unroll
        for (int e = 0; e < 8; ++e) ss += f[e] * f[e];
        const float rstd = 1.f / sqrtf(wave_sum(ss) * (1.f / 512.f) + EPS);
        v4u o; o.x = pk2(f[0] * rstd * g[0], f[1] * rstd * g[1]); o.y = pk2(f[2] * rstd * g[2], f[3] * rstd * g[3]); o.z = pk2(f[4] * rstd * g[4], f[5] * rstd * g[5]); o.w = pk2(f[6] * rstd * g[6], f[7] * rstd * g[7]);
        *(v4u*)lp = o; }
    if (lane < 32) { const int j = lane; bf16* kp = P + CKR_OFF;
        const float ang = (float)s * inv_freq(10000.f, 2 * j, 64); const float cs = cosf(ang), sn = sinf(ang);
        const float x1 = bf2f(kp[j]), x2 = bf2f(kp[j + 32]);
        const bf16 o1 = (bf16)f2bf(x1 * cs - x2 * sn), o2 = (bf16)f2bf(x1 * sn + x2 * cs);
        kp[j] = o1; kp[j + 32] = o2;
#pragma unroll
        for (int h = 0; h < 6; ++h) { KCrow[h * 192 + 128 + j] = o1; KCrow[h * 192 + 160 + j] = o2; } }
}
__device__ __forceinline__ void prep2_row(bf16* Qrow, int s, int lane) {
#pragma unroll
    for (int i = 0; i < 3; ++i) { const int idx = lane + 64 * i, h = idx >> 5, j = idx & 31; bf16* qp = Qrow + h * 192 + 128;
        const float ang = (float)s * inv_freq(10000.f, 2 * j, 64); const float cs = cosf(ang), sn = sinf(ang);
        const float x1 = bf2f(qp[j]), x2 = bf2f(qp[j + 32]);
        qp[j] = (bf16)f2bf(x1 * cs - x2 * sn); qp[j + 32] = (bf16)f2bf(x1 * sn + x2 * cs); }
}
__device__ __forceinline__ void outnorm_row(const float* Yrow, const float* OB, const float* LSE, int t, const float* g, bf16* YNrow, int lane) {
    f32x4 a[3], c[3], b[2];
    float sa = 0.f, sb = 0.f, scc = 0.f;
#pragma unroll
    for (int k = 0; k < 3; ++k) { a[k] = ((const f32x4*)Yrow)[lane + 64 * k]; sa += (a[k].x * a[k].x + a[k].y * a[k].y) + (a[k].z * a[k].z + a[k].w * a[k].w);
                                  c[k] = ((const f32x4*)(Yrow + 1280))[lane + 64 * k]; scc += (c[k].x * c[k].x + c[k].y * c[k].y) + (c[k].z * c[k].z + c[k].w * c[k].w); }
#pragma unroll
    for (int k = 0; k < 2; ++k) { const int idx = lane + 64 * k, h = idx >> 5;
        const float l0 = LSE[((size_t)0 * T + t) * 4 + h], l1 = LSE[((size_t)1 * T + t) * 4 + h], l2 = LSE[((size_t)2 * T + t) * 4 + h];
        const float mx = fmaxf(l0, fmaxf(l1, l2)); const float e0 = __expf(l0 - mx), e1 = __expf(l1 - mx), e2 = __expf(l2 - mx); const float inv = 1.f / (e0 + e1 + e2);
        const f32x4 o0 = ((const f32x4*)(OB + ((size_t)0 * T + t) * 512))[idx], o1 = ((const f32x4*)(OB + ((size_t)1 * T + t) * 512))[idx], o2 = ((const f32x4*)(OB + ((size_t)2 * T + t) * 512))[idx];
        b[k] = o0 * (e0 * inv) + o1 * (e1 * inv) + o2 * (e2 * inv);
        sb += (b[k].x * b[k].x + b[k].y * b[k].y) + (b[k].z * b[k].z + b[k].w * b[k].w); }
    const float ra = 1.f / sqrtf(wave_sum(sa) * (1.f / 768.f) + EPS), rb = 1.f / sqrtf(wave_sum(sb) * (1.f / 512.f) + EPS), rc = 1.f / sqrtf(wave_sum(scc) * (1.f / 768.f) + EPS);
#pragma unroll
    for (int k = 0; k < 3; ++k) { const int idx = lane + 64 * k; const f32x4 ga = ((const f32x4*)g)[idx], gc = ((const f32x4*)(g + 1280))[idx];
        v2u w; w.x = pk2(a[k].x * ra * ga.x, a[k].y * ra * ga.y); w.y = pk2(a[k].z * ra * ga.z, a[k].w * ra * ga.w); ((v2u*)YNrow)[idx] = w;
        v2u w2; w2.x = pk2(c[k].x * rc * gc.x, c[k].y * rc * gc.y); w2.y = pk2(c[k].z * rc * gc.z, c[k].w * rc * gc.w); ((v2u*)(YNrow + 1280))[idx] = w2; }
#pragma unroll
    for (int k = 0; k < 2; ++k) { const int idx = lane + 64 * k; const f32x4 gb = ((const f32x4*)(g + 768))[idx];
        v2u w; w.x = pk2(b[k].x * rb * gb.x, b[k].y * rb * gb.y); w.y = pk2(b[k].z * rb * gb.z, b[k].w * rb * gb.w); ((v2u*)(YNrow + 768))[idx] = w; }
}
__device__ __forceinline__ void unpack8(const v4u r, float* f) { f[0] = bflo(r.x); f[1] = bfhi(r.x); f[2] = bflo(r.y); f[3] = bfhi(r.y); f[4] = bflo(r.z); f[5] = bfhi(r.z); f[6] = bflo(r.w); f[7] = bfhi(r.w); }
__device__ __forceinline__ void convact_item(const bf16* H, const float* cw, const float* cb, bf16* ACT, int t, int c8) {
    const int s = t % SEQ, c = c8 * 8;
    float g[8], u[8];
#pragma unroll
    for (int e = 0; e < 8; ++e) { g[e] = cb[c + e]; u[e] = cb[DFF + c + e]; }
#pragma unroll
    for (int k = 0; k < 3; ++k) { const int dt = k - 1; if ((s + dt) < 0 || (s + dt) >= SEQ) continue;
        const bf16* hr = H + (size_t)(t + dt) * NUP;
        float hg[8], hu[8]; unpack8(*(const v4u*)(hr + c), hg); unpack8(*(const v4u*)(hr + DFF + c), hu);
#pragma unroll
        for (int e = 0; e < 8; ++e) { g[e] += cw[(size_t)k * NUP + c + e] * hg[e]; u[e] += cw[(size_t)k * NUP + DFF + c + e] * hu[e]; } }
    float a[8];
#pragma unroll
    for (int e = 0; e < 8; ++e) a[e] = g[e] / (1.f + __expf(-g[e])) * u[e];
    v4u o; o.x = pk2(a[0], a[1]); o.y = pk2(a[2], a[3]); o.z = pk2(a[4], a[5]); o.w = pk2(a[6], a[7]);
    *(v4u*)(ACT + (size_t)t * DFF + c) = o;
}

constexpr int NPH = 1 + 12 * DEPTH;
#ifndef PH_MASK
#define PH_MASK 0xffff
#endif
#define PH_EN(k) (((PH_MASK) >> (k)) & 1)
#ifndef ATT_MASK
#define ATT_MASK 7
#endif
#ifndef SD128
#define SD128 2
#endif
#ifndef SD192
#define SD192 1
#endif
#ifndef NQR128
#define NQR128 4
#endif
#ifndef NQR192
#define NQR192 4
#endif
#define ATT_EN(k) (((ATT_MASK) >> (k)) & 1)

__global__ void __launch_bounds__(NTHR, 2) fwd(Args a) {
    extern __shared__ __attribute__((aligned(16))) unsigned char lds[];
    cg::grid_group grid = cg::this_grid();
    const int G = gridDim.x, bx = blockIdx.x;
    const int NGW = G * NWAVES;
    unsigned char* ws = a.ws;
    bf16* XN = (bf16*)(ws + WS_XN); float* X = (float*)(ws + WS_X); bf16* PROJ = (bf16*)(ws + WS_PROJ);
    bf16* QC = (bf16*)(ws + WS_QC); bf16* KC = (bf16*)(ws + WS_KC); bf16* VC = (bf16*)(ws + WS_VC);
    float* OB = (float*)(ws + WS_OB); float* LSE = (float*)(ws + WS_LSE); bf16* H = (bf16*)(ws + WS_H);
    float* Y = (float*)(ws + WS_Y); bf16* YN = (bf16*)(ws + WS_YN); bf16* ACT = (bf16*)(ws + WS_ACT);
    pg8::bf16_t* const ldsg = nullptr; (void)ldsg;

    for (int ph = a.ph_lo; ph < a.ph_hi; ++ph) {
        int tid_ = threadIdx.x; asm volatile("" : "+v"(tid_));
        const int tid = tid_, lane = tid & 63, wave = __builtin_amdgcn_readfirstlane(tid >> 6);
        const int gw = bx * NWAVES + wave;
        const int l = (ph - 1) / 12, k = (ph == 0) ? -1 : (ph - 1) % 12;
        unsigned char* wl = ws + WS_W + (size_t)(l < 0 ? 0 : l) * WL_SIZE;
        if (ph == 0 && PH_EN(12)) {
            float* scr = (float*)(lds + wave * 16384);
            constexpr int I_IN = (DM / 64) * (NIN / 32), I_UQ = (CQR / 64) * (NUQ / 32), I_UKV = (CQR / 64) * (NUKV / 32), I_OUT = (DM / 64) * (DM / 32), I_UP = (DM / 64) * (NUP / 32), I_DN = (DFF / 64) * (DM / 32);
            constexpr int I_L = I_IN + I_UQ + I_UKV + I_OUT + I_UP + I_DN;
            for (int it = gw; it < DEPTH * I_L; it += NGW) {
                const int ll = it / I_L; int r = it % I_L; unsigned char* wb = ws + WS_W + (size_t)ll * WL_SIZE;
                if (r < I_IN) { p0_transpose_item(a.w_in + (size_t)ll * DM * NIN, DM, NIN, (bf16*)(wb + WL_IN), scr, r, lane); continue; } r -= I_IN;
                if (r < I_UQ) { p0_transpose_item(a.w_uq + (size_t)ll * CQR * NUQ, CQR, NUQ, (bf16*)(wb + WL_UQ), scr, r, lane); continue; } r -= I_UQ;
                if (r < I_UKV) { p0_transpose_item(a.w_ukv + (size_t)ll * CQR * NUKV, CQR, NUKV, (bf16*)(wb + WL_UKV), scr, r, lane); continue; } r -= I_UKV;
                if (r < I_OUT) { p0_transpose_item(a.w_out + (size_t)ll * DM * DM, DM, DM, (bf16*)(wb + WL_OUT), scr, r, lane); continue; } r -= I_OUT;
                if (r < I_UP) { p0_transpose_item(a.w_up + (size_t)ll * DM * NUP, DM, NUP, (bf16*)(wb + WL_UP), scr, r, lane); continue; } r -= I_UP;
                p0_transpose_item(a.w_down + (size_t)ll * DFF * DM, DFF, DM, (bf16*)(wb + WL_DN), scr, r, lane);
            }
            for (int ll = 0; ll < DEPTH; ++ll) {
                unsigned char* wb = ws + WS_W + (size_t)ll * WL_SIZE;
                v4u* z1 = (v4u*)(wb + WL_IN + (size_t)NIN * DM * 2); const int n1 = (NINP - NIN) * DM * 2 / 16;
                for (int i = bx * NTHR + tid; i < n1; i += G * NTHR) z1[i] = (v4u){0u, 0u, 0u, 0u};
                v4u* z2 = (v4u*)(wb + WL_UQ + (size_t)NUQ * CQR * 2); const int n2 = (NUQP - NUQ) * CQR * 2 / 16;
                for (int i = bx * NTHR + tid; i < n2; i += G * NTHR) z2[i] = (v4u){0u, 0u, 0u, 0u};
            }
            for (int m = gw; m < T; m += NGW) rms_row_bf16(a.x + (size_t)m * DM, a.attn_norm, XN + (size_t)m * DM, lane);
        } else if (k == 0 && PH_EN(0)) {
            pg8::Gemm g{XN, (const pg8::bf16_t*)(wl + WL_IN), T, NINP, DM, DM}; pg8::StaticOrder S; S.init(T, NINP, G, bx);
            pg8::EpiBf16G<0> E{PROJ, NINP, NINP, nullptr, 0};
            pg8::gemm_phase<pg8::EpiBf16G<0>, pg8::StaticOrder, true, true>((LAS unsigned char*)lds, g, S, E);
        } else if (k == 1 && PH_EN(1)) {
            for (int m = gw; m < T; m += NGW) prep_row(PROJ + (size_t)m * NINP, KC + (size_t)m * NUQ, m % SEQ, a.a_q_norm + l * 128, a.a_k_norm + l * 128, a.c_q_norm + l * CQR, a.c_kv_norm + l * CQR, lane);
        } else if (k == 2 && PH_EN(2)) {
            { pg8::Gemm g{PROJ + CQ_OFF, (const pg8::bf16_t*)(wl + WL_UQ), T, NUQP, CQR, NINP}; pg8::StaticOrder S; S.init(T, NUQP, G, bx);
              pg8::EpiBf16G<0> E{QC, NUQ, NUQ, nullptr, 0};
              pg8::gemm_phase<pg8::EpiBf16G<0>, pg8::StaticOrder, true, true>((LAS unsigned char*)lds, g, S, E); }
            { pg8::Gemm g{PROJ + CKV_OFF, (const pg8::bf16_t*)(wl + WL_UKV), T, NUKV, CQR, NINP}; pg8::StaticOrder S; S.init(T, NUKV, G, bx);
              pg8::EpiBf16G<1> E{KC, NUQ, 0, VC, 768};
              pg8::gemm_phase<pg8::EpiBf16G<1>, pg8::StaticOrder, true, true>((LAS unsigned char*)lds, g, S, E); }
        } else if (k == 3 && PH_EN(3)) {
            for (int m = gw; m < T; m += NGW) prep2_row(QC + (size_t)m * NUQ, m % SEQ, lane);
        } else if (k == 4 && PH_EN(4)) {
            for (int u = bx; u < 768; u += G) {
                if (u < 192 && ATT_EN(0)) { const int b = u / 48, h = (u % 48) / 8, qb = u % 8; const size_t r0 = (size_t)b * SEQ;
                    att::attn_dense_unit<192, NUQ, NUQ, 768, DM>(QC + (r0 + qb * 256) * NUQ + h * 192, KC + r0 * NUQ + h * 192, VC + r0 * 768 + h * 128,
                                              Y + (r0 + qb * 256) * DM + 1280 + h * 128, 0.07216878364870322f, (char*)lds, a.ph_hi > 0 ? SEQ : 0);
                } else if (u < 384 && ATT_EN(1)) { const int v = u - 192, b = v / 48, h = (v % 48) / 8, qb = v % 8, kvh = h / 3; const size_t r0 = (size_t)b * SEQ;
                    att::attn_dense_unit<128, NINP, NINP, NINP, DM>(PROJ + (r0 + qb * 256) * NINP + AQ_OFF + h * 128, PROJ + r0 * NINP + AK_OFF + kvh * 128, PROJ + r0 * NINP + AV_OFF + kvh * 128,
                                              Y + (r0 + qb * 256) * DM + h * 128, 0.088388347648318440f, (char*)lds, a.ph_hi > 0 ? SEQ : 0);
                } else if (ATT_EN(2)) { const int wu = (u - 384) * 8 + wave;
                    const int g = wu / 1024, rem = wu % 1024, b = rem / 256, h = (rem % 256) / 64, blk = rem % 64;
                    const int dil = (g == 0) ? 1 : (g == 1) ? 4 : 16, L = SEQ / dil, nqb = L / 32, res = blk / nqb, qb = blk % nqb;
                    const size_t row0 = (size_t)b * SEQ + res;
                    att::banded_wave_unit(PROJ + row0 * NINP + BQ_OFF + (g * 4 + h) * 128, (long)dil * NINP, PROJ + row0 * NINP + BK_OFF + h * 128, (long)dil * NINP,
                                          PROJ + row0 * NINP + BV_OFF + h * 128, (long)dil * NINP, qb * 32, L,
                                          OB + ((size_t)g * T + row0) * 512 + h * 128, (long)dil * 512, LSE + ((size_t)g * T + row0) * 4 + h, (long)dil * 4, (char*)lds + wave * 8448);
                }
            }
        } else if (k == 5 && PH_EN(5)) {
            for (int m = gw; m < T; m += NGW) outnorm_row(Y + (size_t)m * DM, OB, LSE, m, a.out_norm + l * DM, YN + (size_t)m * DM, lane);
        } else if (k == 6 && PH_EN(6)) {
            pg8::Gemm g{YN, (const pg8::bf16_t*)(wl + WL_OUT), T, DM, DM, DM}; pg8::StaticOrder S; S.init(T, DM, G, bx);
            pg8::EpiF32Res E{(l == 0) ? a.x : X, X, DM};
            pg8::gemm_phase<pg8::EpiF32Res, pg8::StaticOrder, true, true>((LAS unsigned char*)lds, g, S, E);
        } else if (k == 7 && PH_EN(7)) {
            for (int m = gw; m < T; m += NGW) rms_row_bf16(X + (size_t)m * DM, a.ffn_norm + l * DM, XN + (size_t)m * DM, lane);
        } else if (k == 8 && PH_EN(8)) {
            pg8::Gemm g{XN, (const pg8::bf16_t*)(wl + WL_UP), T, NUP, DM, DM}; pg8::StaticOrder S; S.init(T, NUP, G, bx);
            pg8::EpiBf16G<0> E{H, NUP, NUP, nullptr, 0};
            pg8::gemm_phase<pg8::EpiBf16G<0>, pg8::StaticOrder, true, true>((LAS unsigned char*)lds, g, S, E);
        } else if (k == 9 && PH_EN(9)) {
            const float* cw = a.conv_w + (size_t)l * 3 * NUP; const float* cb = a.conv_b + (size_t)l * NUP;
            for (int it = bx * NTHR + tid; it < T * (DFF / 8); it += G * NTHR) convact_item(H, cw, cb, ACT, it / (DFF / 8), it % (DFF / 8));
        } else if (k == 10 && PH_EN(10)) {
            pg8::Gemm g{ACT, (const pg8::bf16_t*)(wl + WL_DN), T, DM, DFF, DFF}; pg8::StaticOrder S; S.init(T, DM, G, bx);
            pg8::EpiF32Res E{X, X, DM};
            pg8::gemm_phase<pg8::EpiF32Res, pg8::StaticOrder, true, true>((LAS unsigned char*)lds, g, S, E);
        } else {
            if (l + 1 < DEPTH) { for (int m = gw; m < T; m += NGW) rms_row_bf16(X + (size_t)m * DM, a.attn_norm + (l + 1) * DM, XN + (size_t)m * DM, lane); }
            else { for (int m = gw; m < T; m += NGW) rms_row_f32(X + (size_t)m * DM, a.final_norm, a.out + (size_t)m * DM, lane); }
        }
        if (ph + 1 < a.ph_hi) grid.sync();
    }
}

#ifndef N_LAUNCH_MODE
#define N_LAUNCH_MODE 1
#endif
extern "C" void kernel_launch(void* const* d_in, const int* in_sizes, int n_in, void* d_out, int out_size, void* d_ws, size_t ws_size, hipStream_t stream) {
    static int grid = 0;
    if (grid == 0) {
        if (n_in != 17 || out_size != T * DM || ws_size < WS_END) { fprintf(stderr, "kernel_launch: unexpected shapes: n_in %d out %d ws %zu (need %zu)\n", n_in, out_size, ws_size, (size_t)WS_END); grid = -1; return; }
        int dev = 0, cus = 0, per_cu = 0;
        if (hipGetDevice(&dev) != hipSuccess || hipDeviceGetAttribute(&cus, hipDeviceAttributeMultiprocessorCount, dev) != hipSuccess) { grid = -1; return; }
        if (hipFuncSetAttribute((const void*)fwd, hipFuncAttributeMaxDynamicSharedMemorySize, LDS_BYTES) != hipSuccess) { fprintf(stderr, "kernel_launch: hipFuncSetAttribute failed\n"); grid = -1; return; }
        if (hipOccupancyMaxActiveBlocksPerMultiprocessor(&per_cu, (const void*)fwd, NTHR, LDS_BYTES) != hipSuccess || per_cu < 1) { fprintf(stderr, "kernel_launch: occupancy query says %d\n", per_cu); (void)hipGetLastError(); }
        grid = cus;
        fprintf(stderr, "kernel_launch: grid %d per_cu %d ws %zu need %zu\n", grid, per_cu, ws_size, (size_t)WS_END);
    }
    if (grid < 0) return;
    Args a{};
    a.x = (const float*)d_in[0]; a.attn_norm = (const float*)d_in[1]; a.w_in = (const float*)d_in[2]; a.a_q_norm = (const float*)d_in[3]; a.a_k_norm = (const float*)d_in[4];
    a.c_q_norm = (const float*)d_in[5]; a.c_kv_norm = (const float*)d_in[6]; a.w_uq = (const float*)d_in[7]; a.w_ukv = (const float*)d_in[8]; a.out_norm = (const float*)d_in[9];
    a.w_out = (const float*)d_in[10]; a.ffn_norm = (const float*)d_in[11]; a.w_up = (const float*)d_in[12]; a.conv_w = (const float*)d_in[13]; a.conv_b = (const float*)d_in[14];
    a.w_down = (const float*)d_in[15]; a.final_norm = (const float*)d_in[16];
    a.out = (float*)d_out; a.ws = (unsigned char*)d_ws;
#if N_LAUNCH_MODE == 1
    a.ph_lo = 0; a.ph_hi = NPH;
    { void* args[] = {&a}; hipError_t e = hipLaunchCooperativeKernel((void*)fwd, dim3(grid), dim3(NTHR), args, LDS_BYTES, stream);
      if (e != hipSuccess) fprintf(stderr, "kernel_launch: cooperative launch failed: %s\n", hipGetErrorString(e)); }
#else
    for (int ph = 0; ph < NPH; ++ph) { a.ph_lo = ph; a.ph_hi = ph + 1; void* args[] = {&a};
        hipError_t e = hipLaunchCooperativeKernel((void*)fwd, dim3(grid), dim3(NTHR), args, LDS_BYTES, stream);
        if (e != hipSuccess) { fprintf(stderr, "kernel_launch: launch %d failed: %s\n", ph, hipGetErrorString(e)); break; } }
#endif
}
```

```cpp
#include <hip/hip_runtime.h>
#include <hip/hip_cooperative_groups.h>
#include <hip/hip_bf16.h>
#include <cstdio>
#include <cstdint>
#include <cmath>
namespace cg = cooperative_groups;
namespace pg8 {
#define PG8_LAS __attribute__((address_space(3)))
typedef unsigned short bf16_t;
typedef short bf16x8 __attribute__((ext_vector_type(8)));
typedef float f32x4 __attribute__((ext_vector_type(4)));
typedef unsigned u32x4 __attribute__((ext_vector_type(4)));
constexpr int BM = 256, BK = 64, HALF = 128, HTB = HALF * BK * 2  , STAGE_BYTES = 8 * HTB, NXCD = 8, WGM = 8;

__host__ __device__ __forceinline__ int lds_byte(int r, int c) { const int st = (r >> 4) * 2 + (c >> 5), rr = r & 15, cc = c & 31, ob = rr * 64 + cc * 2; return st * 1024 + (ob ^ (((ob >> 9) & 1) << 5)); }
__host__ __device__ __forceinline__ void stage_rc(int b, int& R, int& C) { const int st = b / 1024, sb = b % 1024, swz = sb ^ (((sb >> 9) & 1) << 5); R = (st >> 1) * 16 + swz / 64; C = (st & 1) * 32 + (swz % 64) / 2; }
__host__ __device__ __forceinline__ int perm32(int rho) { const int n = rho >> 4, i = rho & 15; return 8 * (i >> 2) + 4 * n + (i & 3); }

struct Unit { int pm, pn; };
struct Gemm { const bf16_t* A; const bf16_t* Bt; int M, N, K, lda; };

struct StaticOrder {
    int nM, nN, nwg, G, c;
    __host__ __device__ void init(int M, int N, int G_, int c_) { nM = M / BM; nN = N / BM; nwg = nM * nN; G = G_; c = c_; }
    __host__ __device__ bool next(int i, Unit& u) const {
        const long L = (long)i * G + c; if (L >= nwg) return false;
        int wgid = (int)L; { const int q = nwg / NXCD, r = nwg % NXCD, xcd = wgid % NXCD, off = wgid / NXCD; wgid = (xcd < r ? xcd * (q + 1) : r * (q + 1) + (xcd - r) * q) + off; }
        const int nig = WGM * nN, gid = wgid / nig, fm = gid * WGM, gsz = (nM - fm) < WGM ? (nM - fm) : WGM;
        u.pm = fm + ((wgid % nig) % gsz); u.pn = (wgid % nig) / gsz; return true;
    }
    __device__ __forceinline__ void a_ready(const Unit&) const {}
    __device__ __forceinline__ void done(const Unit&) const {}
};

__device__ __forceinline__ unsigned cvt_pk_bf16(float lo, float hi) { unsigned r; asm volatile("v_cvt_pk_bf16_f32 %0, %1, %2" : "=v"(r) : "v"(lo), "v"(hi)); return r; }

template <int MODE> struct EpiBf16G {
    static constexpr bool PERM = true, AFTER_DRAIN = false, USES_LDS = false;
    bf16_t* O; int ldc; int ncols; bf16_t* O2; int ldc2;
    __device__ __forceinline__ void operator()(const f32x4 (&acc)[2][2][4][2], const Unit& u, int wr, int wc, int fr, int fq) const {
        const int row0 = u.pm * BM + wr * 64 + fr;
#pragma unroll
        for (int ai = 0; ai < 2; ++ai)
#pragma unroll
            for (int m = 0; m < 4; ++m) { const size_t row = (size_t)(row0 + ai * HALF + m * 16);
#pragma unroll
                for (int bj = 0; bj < 2; ++bj) {
                    const f32x4 v0 = acc[ai][bj][m][0], v1 = acc[ai][bj][m][1];
                    u32x4 w; w.x = cvt_pk_bf16(v0[0], v0[1]); w.y = cvt_pk_bf16(v0[2], v0[3]); w.z = cvt_pk_bf16(v1[0], v1[1]); w.w = cvt_pk_bf16(v1[2], v1[3]);
                    if (MODE == 0) { const int col = u.pn * BM + bj * HALF + wc * 32 + 8 * fq; if (col < ncols) *(u32x4*)(O + row * ldc + col) = w; }
                    else { if (bj == 0) *(u32x4*)(O + row * ldc + u.pn * 192 + wc * 32 + 8 * fq) = w; else *(u32x4*)(O2 + row * ldc2 + u.pn * 128 + wc * 32 + 8 * fq) = w; }
                } }
    }
};
template <bool BASE_F32> struct EpiRes {
    static constexpr bool PERM = false, AFTER_DRAIN = false, USES_LDS = false;
    const void* base; bf16_t* out; int ldc;
    __device__ __forceinline__ void operator()(const f32x4 (&acc)[2][2][4][2], const Unit& u, int wr, int wc, int fr, int fq) const {
        typedef unsigned u32x2v __attribute__((ext_vector_type(2)));
        const int row0 = u.pm * BM + wr * 64 + fr, col0 = u.pn * BM + wc * 32 + 4 * fq;
#pragma unroll
        for (int ai = 0; ai < 2; ++ai)
#pragma unroll
            for (int m = 0; m < 4; ++m) { const size_t off = (size_t)(row0 + ai * HALF + m * 16) * ldc + col0;
#pragma unroll
                for (int bj = 0; bj < 2; ++bj)
#pragma unroll
                    for (int n = 0; n < 2; ++n) { f32x4 b;
                        if (BASE_F32) b = *(const f32x4*)((const float*)base + off + bj * HALF + n * 16);
                        else { const u32x2v r = *(const u32x2v*)((const bf16_t*)base + off + bj * HALF + n * 16);
                               b = (f32x4){__builtin_bit_cast(float, r.x << 16), __builtin_bit_cast(float, r.x & 0xffff0000u), __builtin_bit_cast(float, r.y << 16), __builtin_bit_cast(float, r.y & 0xffff0000u)}; }
                        const f32x4 v = b + acc[ai][bj][m][n]; u32x2v w; w.x = cvt_pk_bf16(v[0], v[1]); w.y = cvt_pk_bf16(v[2], v[3]);
                        *(u32x2v*)(out + off + bj * HALF + n * 16) = w; } }
    }
};
__device__ __forceinline__ float dpp_prev(float x, float xm) {
    const int e = __builtin_amdgcn_mov_dpp(__builtin_bit_cast(int, xm), 0x121, 0xf, 0xf, false);
    return __builtin_bit_cast(float, __builtin_amdgcn_update_dpp(e, __builtin_bit_cast(int, x), 0x111, 0xf, 0xf, false)); }
__device__ __forceinline__ float dpp_next(float x, float xp) {
    const int e = __builtin_amdgcn_mov_dpp(__builtin_bit_cast(int, xp), 0x12f, 0xf, 0xf, false);
    return __builtin_bit_cast(float, __builtin_amdgcn_update_dpp(e, __builtin_bit_cast(int, x), 0x101, 0xf, 0xf, false)); }
struct EpiConvAct {
    static constexpr bool PERM = true, AFTER_DRAIN = false, USES_LDS = true;
    bf16_t* ACT; float* HB; const float* cw; const float* cb; int dff, nup;
    __device__ __forceinline__ void run(const f32x4 (&acc)[2][2][4][2], const Unit& u, int wr, int wc, int fr_, int fq_, PG8_LAS unsigned char* xl, int wid, int lane) const {
        int fr = fr_, fq = fq_; asm volatile("" : "+v"(fr), "+v"(fq));
        PG8_LAS float* X = (PG8_LAS float*)xl;
#pragma unroll
        for (int ai = 0; ai < 2; ++ai)
#pragma unroll
            for (int bj = 0; bj < 2; ++bj)
#pragma unroll
                for (int n = 0; n < 2; ++n) {
                    if (fr == 0)  *(PG8_LAS f32x4*)(X + ((((wid * 2 + ai) * 2 + 0) * 2 + bj) * 2 + n) * 16 + fq * 4) = acc[ai][bj][0][n];
                    if (fr == 15) *(PG8_LAS f32x4*)(X + ((((wid * 2 + ai) * 2 + 1) * 2 + bj) * 2 + n) * 16 + fq * 4) = acc[ai][bj][3][n];
                }
        if (wr == 0 && fr < 2) { float* hb = HB + ((size_t)u.pm * 4 + fr) * nup + u.pn * BM + wc * 32 + 8 * fq;
#pragma unroll
            for (int bj = 0; bj < 2; ++bj)
#pragma unroll
                for (int n = 0; n < 2; ++n) *(f32x4*)(hb + bj * HALF + 4 * n) = acc[0][bj][0][n]; }
        if (wr == 1 && fr >= 14) { float* hb = HB + ((size_t)u.pm * 4 + 2 + (fr - 14)) * nup + u.pn * BM + wc * 32 + 8 * fq;
#pragma unroll
            for (int bj = 0; bj < 2; ++bj)
#pragma unroll
                for (int n = 0; n < 2; ++n) *(f32x4*)(hb + bj * HALF + 4 * n) = acc[1][bj][3][n]; }
        asm volatile("s_waitcnt lgkmcnt(0)" ::: "memory"); __builtin_amdgcn_s_barrier(); asm volatile("" ::: "memory");
        const int ch0 = u.pn * HALF + wc * 32 + 8 * fq;
        const int pw = wid ^ 4;
#pragma unroll
        for (int ai = 0; ai < 2; ++ai) {
            unsigned pk[4][2][2];
#pragma unroll
            for (int n = 0; n < 2; ++n) {
                f32x4 wg[3], wu[3];
#pragma unroll
                for (int k = 0; k < 3; ++k) { wg[k] = *(const f32x4*)(cw + (size_t)k * nup + ch0 + 4 * n); wu[k] = *(const f32x4*)(cw + (size_t)k * nup + dff + ch0 + 4 * n); }
                const f32x4 bg = *(const f32x4*)(cb + ch0 + 4 * n), bu = *(const f32x4*)(cb + dff + ch0 + 4 * n);
#pragma unroll
                for (int m = 0; m < 4; ++m) {
                    f32x4 cv[2];
#pragma unroll
                    for (int bj = 0; bj < 2; ++bj) {
                        const f32x4 x = acc[ai][bj][m][n];
                        f32x4 xm, xp; const f32x4 z = (f32x4){0.f, 0.f, 0.f, 0.f};
                        if (m > 0) xm = acc[ai][bj][m > 0 ? m - 1 : 0][n];
                        else if (wr == 1) xm = *(PG8_LAS f32x4*)(X + ((((pw * 2 + ai) * 2 + 1) * 2 + bj) * 2 + n) * 16 + fq * 4);
                        else if (ai == 1) xm = *(PG8_LAS f32x4*)(X + ((((pw * 2 + 0) * 2 + 1) * 2 + bj) * 2 + n) * 16 + fq * 4);
                        else xm = z;
                        if (m < 3) xp = acc[ai][bj][m < 3 ? m + 1 : 3][n];
                        else if (wr == 0) xp = *(PG8_LAS f32x4*)(X + ((((pw * 2 + ai) * 2 + 0) * 2 + bj) * 2 + n) * 16 + fq * 4);
                        else if (ai == 0) xp = *(PG8_LAS f32x4*)(X + ((((pw * 2 + 1) * 2 + 0) * 2 + bj) * 2 + n) * 16 + fq * 4);
                        else xp = z;
                        const f32x4 w0 = bj ? wu[0] : wg[0], w1 = bj ? wu[1] : wg[1], w2 = bj ? wu[2] : wg[2], bb = bj ? bu : bg;
                        f32x4 pv, nx;
#pragma unroll
                        for (int j = 0; j < 4; ++j) { pv[j] = dpp_prev(x[j], xm[j]); nx[j] = dpp_next(x[j], xp[j]); }
                        cv[bj] = bb + w0 * pv + w1 * x + w2 * nx;
                    }
                    f32x4 o; { const f32x4 g = cv[0], t = g * (-1.4426950408889634f); f32x4 d;
#pragma unroll
                      for (int j = 0; j < 4; ++j) d[j] = __builtin_amdgcn_exp2f(t[j]);
                      d = d + 1.f;
#pragma unroll
                      for (int j = 0; j < 4; ++j) d[j] = __builtin_amdgcn_rcpf(d[j]);
                      o = (g * d) * cv[1]; }
                    pk[m][n][0] = cvt_pk_bf16(o[0], o[1]); pk[m][n][1] = cvt_pk_bf16(o[2], o[3]);
                }
            }
#pragma unroll
            for (int m = 0; m < 4; ++m) { u32x4 w; w.x = pk[m][0][0]; w.y = pk[m][0][1]; w.z = pk[m][1][0]; w.w = pk[m][1][1];
                *(u32x4*)(ACT + (size_t)(u.pm * BM + ai * HALF + wr * 64 + m * 16 + fr) * dff + ch0) = w; }
            asm volatile("" ::: "memory");
        }
    }
};
template <class Epi, class Sched, bool ALIGN_EPI = false, bool SP2 = false>
__device__ __forceinline__ void gemm_phase(PG8_LAS unsigned char* lds, const Gemm g, const Sched& S, const Epi& E) {
    int tid_ = threadIdx.x; asm volatile("" : "+v"(tid_));
    const int tid = tid_, wid = __builtin_amdgcn_readfirstlane(tid >> 6), lane = tid & 63, wr = wid >> 2, wc = wid & 3, fr = lane & 15, fq = lane >> 4;
    const int K = g.K, nt = K / BK;
    unsigned voffA[2], voffB[2];
#pragma unroll
    for (int i = 0; i < 2; ++i) { int R, C; stage_rc(tid * 16 + i * 8192, R, C); const int Rb = Epi::PERM ? ((R & ~31) + perm32(R & 31)) : R;
        voffA[i] = (unsigned)(R * g.lda + C) * 2u; voffB[i] = (unsigned)(Rb * K + C) * 2u; }
    const size_t kstep = (size_t)(BK * 2);
    const size_t hstepA = (size_t)HALF * g.lda * 2, hstepB = (size_t)HALF * K * 2;
    const size_t tstepA = 2 * hstepA, tstepB = 2 * hstepB;
    const unsigned ldsw = (unsigned)wid * 1024u;
    const int aoff = lds_byte(wr * 64 + fr, fq * 8), boff = lds_byte(wc * 32 + fr, fq * 8);
#define PG8_SA(b, h) (((b) * 2 + (h)) * HTB)
#define PG8_SB(b, h) ((4 + (b) * 2 + (h)) * HTB)
#define PG8_STAGE(bufoff, gbase, voff) do { _Pragma("unroll") for (int _i = 0; _i < 2; ++_i) \
        __builtin_amdgcn_global_load_lds((const unsigned*)((const char*)(gbase) + (voff)[_i]), (PG8_LAS unsigned*)(lds + (bufoff) + ldsw + _i * 8192), 16, 0, 0); } while (0)
#define PG8_LDA(dst, b, h) do { _Pragma("unroll") for (int m = 0; m < 4; ++m) _Pragma("unroll") for (int k = 0; k < 2; ++k) dst[m][k] = *(const PG8_LAS bf16x8*)(lds + PG8_SA(b, h) + aoff + m * 2048 + k * 1024); } while (0)
#define PG8_LDB(dst, b, h) do { _Pragma("unroll") for (int n = 0; n < 2; ++n) _Pragma("unroll") for (int k = 0; k < 2; ++k) dst[n][k] = *(const PG8_LAS bf16x8*)(lds + PG8_SB(b, h) + boff + n * 2048 + k * 1024); } while (0)
#define PG8_MMA(ai, bj, At, Bt) do { __builtin_amdgcn_s_setprio(1); _Pragma("unroll") for (int m = 0; m < 4; ++m) _Pragma("unroll") for (int n = 0; n < 2; ++n) _Pragma("unroll") for (int k = 0; k < 2; ++k) \
        acc[ai][bj][m][n] = __builtin_amdgcn_mfma_f32_16x16x32_bf16(Bt[n][k], At[m][k], acc[ai][bj][m][n], 0, 0, 0); __builtin_amdgcn_s_setprio(0); } while (0)
#define PG8_WAIT_V(n) asm volatile("s_waitcnt vmcnt(" #n ")" ::: "memory")
#define PG8_WAIT_L(n) asm volatile("s_waitcnt lgkmcnt(" #n ")" ::: "memory")
#define PG8_BAR __builtin_amdgcn_s_barrier()
#define PG8_SCHED __builtin_amdgcn_sched_barrier(0)
    Unit cur, nxt; int ui = 0;
    if (!S.next(0, cur)) return;
    f32x4 acc[2][2][4][2];
#pragma unroll
    for (int a = 0; a < 2; ++a)
#pragma unroll
        for (int b = 0; b < 2; ++b)
#pragma unroll
            for (int m = 0; m < 4; ++m)
#pragma unroll
                for (int n = 0; n < 2; ++n) acc[a][b][m][n] = (f32x4){0.f, 0.f, 0.f, 0.f};
    bf16x8 At[4][2], B0[2][2], B1[2][2];
    const char* cA = (const char*)g.A + (size_t)cur.pm * tstepA; const char* cB = (const char*)g.Bt + (size_t)cur.pn * tstepB;
    S.a_ready(cur);
    if constexpr (SP2) {
        PG8_STAGE(PG8_SB(0, 0), cB, voffB); PG8_STAGE(PG8_SB(0, 1), cB + hstepB, voffB); PG8_STAGE(PG8_SA(0, 0), cA, voffA); PG8_STAGE(PG8_SA(0, 1), cA + hstepA, voffA);
        if (wr == 1) PG8_BAR;
        PG8_WAIT_V(2); PG8_BAR;
        PG8_STAGE(PG8_SB(1, 0), cB + kstep, voffB); PG8_STAGE(PG8_SA(1, 0), cA + kstep, voffA); PG8_STAGE(PG8_SB(1, 1), cB + hstepB + kstep, voffB);
        PG8_WAIT_V(6); PG8_BAR;
    } else {
        PG8_STAGE(PG8_SB(0, 0), cB, voffB); PG8_STAGE(PG8_SA(0, 0), cA, voffA); PG8_STAGE(PG8_SB(0, 1), cB + hstepB, voffB); PG8_STAGE(PG8_SA(0, 1), cA + hstepA, voffA);
        if (wr == 1) PG8_BAR;
        PG8_WAIT_V(4); PG8_BAR;
        PG8_STAGE(PG8_SB(1, 0), cB + kstep, voffB); PG8_STAGE(PG8_SA(1, 0), cA + kstep, voffA); PG8_STAGE(PG8_SB(1, 1), cB + hstepB + kstep, voffB);
        PG8_WAIT_V(6); PG8_BAR;
    }
    for (;;) {
        const bool has_next = S.next(ui + 1, nxt);
        const char* nA = has_next ? (const char*)g.A + (size_t)nxt.pm * tstepA : cA; const char* nB = has_next ? (const char*)g.Bt + (size_t)nxt.pn * tstepB : cB;
        for (int t = 0; t < nt; t += 2) {
            const bool last = (t == nt - 2);
            const char* a1 = cA + (size_t)(t + 1) * kstep;
            const char* a2 = last ? nA : cA + (size_t)(t + 2) * kstep; const char* b2 = last ? nB : cB + (size_t)(t + 2) * kstep;
            const char* a3 = a2 + kstep; const char* b3 = b2 + kstep;
            if (last && has_next) S.a_ready(nxt);
            if constexpr (SP2) {
            PG8_LDB(B0, 0, 0); PG8_LDB(B1, 0, 1); PG8_SCHED; PG8_LDA(At, 0, 0); PG8_STAGE(PG8_SA(1, 1), a1 + hstepA, voffA);
            PG8_WAIT_V(8); PG8_WAIT_L(0); PG8_BAR; PG8_MMA(0, 0, At, B0); PG8_MMA(0, 1, At, B1); PG8_BAR; PG8_SCHED;
            PG8_LDA(At, 0, 1); PG8_STAGE(PG8_SB(0, 0), b2, voffB); PG8_STAGE(PG8_SB(0, 1), b2 + hstepB, voffB); PG8_STAGE(PG8_SA(0, 0), a2, voffA);
            PG8_WAIT_V(8); PG8_WAIT_L(0); PG8_BAR; PG8_MMA(1, 0, At, B0); PG8_MMA(1, 1, At, B1); PG8_BAR; PG8_SCHED;
            PG8_LDB(B0, 1, 0); PG8_LDB(B1, 1, 1); PG8_SCHED; PG8_LDA(At, 1, 0); PG8_STAGE(PG8_SA(0, 1), a2 + hstepA, voffA);
            PG8_WAIT_V(8); PG8_WAIT_L(0); PG8_BAR; PG8_MMA(0, 0, At, B0); PG8_MMA(0, 1, At, B1); PG8_BAR; PG8_SCHED;
            PG8_LDA(At, 1, 1); PG8_STAGE(PG8_SB(1, 0), b3, voffB); PG8_STAGE(PG8_SB(1, 1), b3 + hstepB, voffB); PG8_STAGE(PG8_SA(1, 0), a3, voffA);
            PG8_WAIT_V(8); PG8_WAIT_L(0); PG8_BAR; PG8_MMA(1, 0, At, B0); PG8_MMA(1, 1, At, B1); PG8_BAR; PG8_SCHED;
            } else {
            PG8_LDB(B0, 0, 0); PG8_SCHED; PG8_LDA(At, 0, 0); PG8_STAGE(PG8_SA(1, 1), a1 + hstepA, voffA);
            PG8_WAIT_L(8); PG8_BAR; PG8_WAIT_L(0); PG8_MMA(0, 0, At, B0); PG8_BAR; PG8_SCHED;
            PG8_LDB(B1, 0, 1); PG8_STAGE(PG8_SB(0, 0), b2, voffB);
            PG8_BAR; PG8_WAIT_L(0); PG8_MMA(0, 1, At, B1); PG8_BAR;
            PG8_LDA(At, 0, 1); PG8_STAGE(PG8_SA(0, 0), a2, voffA);
            PG8_BAR; PG8_WAIT_L(0); PG8_MMA(1, 0, At, B0); PG8_BAR; PG8_SCHED;
            PG8_STAGE(PG8_SB(0, 1), b2 + hstepB, voffB);
            PG8_WAIT_V(6); PG8_BAR; PG8_MMA(1, 1, At, B1); PG8_BAR;
            PG8_LDB(B0, 1, 0); PG8_SCHED; PG8_LDA(At, 1, 0); PG8_STAGE(PG8_SA(0, 1), a2 + hstepA, voffA);
            PG8_WAIT_L(8); PG8_BAR; PG8_WAIT_L(0); PG8_MMA(0, 0, At, B0); PG8_BAR; PG8_SCHED;
            PG8_LDB(B1, 1, 1); PG8_STAGE(PG8_SB(1, 0), b3, voffB);
            PG8_BAR; PG8_WAIT_L(0); PG8_MMA(0, 1, At, B1); PG8_BAR;
            PG8_LDA(At, 1, 1); PG8_STAGE(PG8_SA(1, 0), a3, voffA);
            PG8_BAR; PG8_WAIT_L(0); PG8_MMA(1, 0, At, B0); PG8_BAR; PG8_SCHED;
            PG8_STAGE(PG8_SB(1, 1), b3 + hstepB, voffB);
            PG8_WAIT_V(6); PG8_BAR; PG8_MMA(1, 1, At, B1); PG8_BAR;
            }
        }
        if constexpr (ALIGN_EPI) { if (wr == 0) PG8_BAR; }
        if constexpr (!Epi::AFTER_DRAIN) { if constexpr (Epi::USES_LDS) E.run(acc, cur, wr, wc, fr, fq, lds + STAGE_BYTES + 2048, wid, lane); else E(acc, cur, wr, wc, fr, fq); S.done(cur); }
        if (!has_next) break;
#pragma unroll
        for (int a = 0; a < 2; ++a)
#pragma unroll
            for (int b = 0; b < 2; ++b)
#pragma unroll
                for (int m = 0; m < 4; ++m)
#pragma unroll
                    for (int n = 0; n < 2; ++n) acc[a][b][m][n] = (f32x4){0.f, 0.f, 0.f, 0.f};
        cur = nxt; cA = nA; cB = nB; ++ui;
        if constexpr (ALIGN_EPI) { if (wr == 1) PG8_BAR; }
    }
    PG8_WAIT_V(0);
    if constexpr (!ALIGN_EPI) { if (wr == 0) PG8_BAR; }
    PG8_BAR;
    if constexpr (Epi::AFTER_DRAIN) { E.fused(acc, cur, wr, wc, fr, fq, lds, wid, lane); S.done(cur); }
#undef PG8_SA
#undef PG8_SB
#undef PG8_STAGE
#undef PG8_LDA
#undef PG8_LDB
#undef PG8_MMA
#undef PG8_WAIT_V
#undef PG8_WAIT_L
#undef PG8_BAR
#undef PG8_SCHED
}
}
namespace att {
using bf16 = unsigned short;
using bf16x8 = __attribute__((ext_vector_type(8))) short;
using s16x4  = __attribute__((ext_vector_type(4))) short;
using f32x16 = __attribute__((ext_vector_type(16))) float;
using u32x4  = __attribute__((ext_vector_type(4))) unsigned;
constexpr int NW = 8, QBLK = 32, KVBLK = 64, DV = 128;
constexpr float THR = 8.f;
#define SBAR() __builtin_amdgcn_sched_barrier(0)
__device__ __forceinline__ int crow(int r, int hi) { return (r & 3) + 8 * (r >> 2) + 4 * hi; }
__device__ __forceinline__ unsigned cvtpk(float lo, float hi) { unsigned r; asm volatile("v_cvt_pk_bf16_f32 %0, %1, %2" : "=v"(r) : "v"(lo), "v"(hi)); return r; }
__device__ __forceinline__ bf16x8 ld8(const bf16* p) { return *reinterpret_cast<const bf16x8*>(p); }

__device__ __forceinline__ void partialSM(f32x16& p0, f32x16& p1, float& m_reg, float& mn, float& alpha, const float C, const float THRS) {
  float pmax = p0[0];
#pragma unroll
  for (int r = 1; r < 16; ++r) pmax = fmaxf(pmax, p0[r]);
#pragma unroll
  for (int r = 0; r < 16; ++r) pmax = fmaxf(pmax, p1[r]);
  { auto rr = __builtin_amdgcn_permlane32_swap(__float_as_uint(pmax), __float_as_uint(pmax), false, false);
    pmax = fmaxf(__uint_as_float(rr[0]), __uint_as_float(rr[1])); }
  if (__builtin_expect(__all(pmax - m_reg <= THRS), 1)) { mn = m_reg; alpha = 1.f; }
  else { mn = fmaxf(m_reg, pmax); alpha = __builtin_amdgcn_exp2f((m_reg - mn) * C); m_reg = mn; }
  float mnC = -mn * C;
#pragma unroll
  for (int r = 0; r < 16; ++r) p0[r] = fmaf(p0[r], C, mnC);
#pragma unroll
  for (int r = 0; r < 16; ++r) p1[r] = fmaf(p1[r], C, mnC);
#pragma unroll
  for (int r = 0; r < 16; ++r) p0[r] = __builtin_amdgcn_exp2f(p0[r]);
}
#define PK4(P, BASE, OUT) do { unsigned a0 = cvtpk(P[BASE + 0], P[BASE + 1]), a1 = cvtpk(P[BASE + 2], P[BASE + 3]);   \
    unsigned b0 = cvtpk(P[BASE + 4], P[BASE + 5]), b1 = cvtpk(P[BASE + 6], P[BASE + 7]);                              \
    auto r0 = __builtin_amdgcn_permlane32_swap(a0, b0, false, false); auto r1 = __builtin_amdgcn_permlane32_swap(a1, b1, false, false); \
    u32x4 w = {r0[0], r1[0], r0[1], r1[1]}; OUT = *reinterpret_cast<bf16x8*>(&w); } while (0)
__device__ __forceinline__ void finishSM(f32x16& p0, f32x16& p1, float alpha, float& l_reg, bf16x8& pa0, bf16x8& pa1, bf16x8& pa2, bf16x8& pa3) {
#pragma unroll
  for (int r = 0; r < 16; ++r) p1[r] = __builtin_amdgcn_exp2f(p1[r]);
  float ps = 0;
#pragma unroll
  for (int r = 0; r < 16; ++r) ps += p0[r];
#pragma unroll
  for (int r = 0; r < 16; ++r) ps += p1[r];
  { auto rr = __builtin_amdgcn_permlane32_swap(__float_as_uint(ps), __float_as_uint(ps), false, false);
    ps = __uint_as_float(rr[0]) + __uint_as_float(rr[1]); }
  l_reg = l_reg * alpha + ps;
  PK4(p0, 0, pa0); PK4(p0, 8, pa1); PK4(p1, 0, pa2); PK4(p1, 8, pa3);
}
template <int DK> __device__ __forceinline__ int kswz(int row, int colB) { return row * (DK * 2) + (colB ^ ((row & 7) << 4)); }
template <int DK> __device__ __forceinline__ void qkt(f32x16& p0, f32x16& p1, const char* Ks, const bf16x8* qr, int r32, int hi) {
  p0 = f32x16{}; p1 = f32x16{};
#pragma unroll
  for (int d0 = 0; d0 < DK / 16; ++d0) { int cb = (d0 * 16 + hi * 8) * 2;
    bf16x8 b0 = *reinterpret_cast<const bf16x8*>(Ks + kswz<DK>(r32, cb));
    bf16x8 b1 = *reinterpret_cast<const bf16x8*>(Ks + kswz<DK>(32 + r32, cb));
    p0 = __builtin_amdgcn_mfma_f32_32x32x16_bf16(b0, qr[d0], p0, 0, 0, 0);
    p1 = __builtin_amdgcn_mfma_f32_32x32x16_bf16(b1, qr[d0], p1, 0, 0, 0); }
}
__device__ __forceinline__ int v_st(int k, int c) { const int kk = (k & ~0xC) | ((k & 4) << 1) | ((k & 8) >> 1); return ((kk >> 3) * 4 + (c >> 5)) * 512 + ((kk & 7) * 32 + (c & 31)) * 2; }
__device__ __forceinline__ int v_rd_base(int lane) { return ((lane & 3) << 3) | (((lane >> 2) & 3) << 6) | (((lane >> 4) & 1) << 5) | (((lane >> 5) & 1) << 8); }
constexpr int v_rd_off(int d0, int ks, int half) { return d0 * 512 + ks * 4096 + half * 2048; }
template <int OFF> __device__ __forceinline__ s16x4 tr_read(int vb) {
  s16x4 r; asm volatile("ds_read_b64_tr_b16 %0, %1 offset:%2" : "=&v"(r) : "v"(vb), "i"(OFF) : "memory"); return r;
}
#define PKV(L, H) (bf16x8){L[0], L[1], L[2], L[3], H[0], H[1], H[2], H[3]}
template <int D0> __device__ __forceinline__ void pv_one(f32x16& od, int vb, bf16x8 pa0, bf16x8 pa1, bf16x8 pa2, bf16x8 pa3) {
  const s16x4 l0 = tr_read<v_rd_off(D0, 0, 0)>(vb), h0 = tr_read<v_rd_off(D0, 0, 1)>(vb), l1 = tr_read<v_rd_off(D0, 1, 0)>(vb), h1 = tr_read<v_rd_off(D0, 1, 1)>(vb);
  const s16x4 l2 = tr_read<v_rd_off(D0, 2, 0)>(vb), h2 = tr_read<v_rd_off(D0, 2, 1)>(vb), l3 = tr_read<v_rd_off(D0, 3, 0)>(vb), h3 = tr_read<v_rd_off(D0, 3, 1)>(vb);
  asm volatile("s_waitcnt lgkmcnt(0)" ::: "memory"); SBAR();
  od = __builtin_amdgcn_mfma_f32_32x32x16_bf16(pa0, PKV(l0, h0), od, 0, 0, 0);
  od = __builtin_amdgcn_mfma_f32_32x32x16_bf16(pa1, PKV(l1, h1), od, 0, 0, 0);
  od = __builtin_amdgcn_mfma_f32_32x32x16_bf16(pa2, PKV(l2, h2), od, 0, 0, 0);
  od = __builtin_amdgcn_mfma_f32_32x32x16_bf16(pa3, PKV(l3, h3), od, 0, 0, 0);
}
__device__ __forceinline__ void pv_d0(f32x16* o, int vb, bf16x8 pa0, bf16x8 pa1, bf16x8 pa2, bf16x8 pa3) {
  pv_one<0>(o[0], vb, pa0, pa1, pa2, pa3); pv_one<1>(o[1], vb, pa0, pa1, pa2, pa3); pv_one<2>(o[2], vb, pa0, pa1, pa2, pa3); pv_one<3>(o[3], vb, pa0, pa1, pa2, pa3);
}

template <int DK, int ldq, int ldk, int ldv, int ldo>
__device__ __forceinline__ void attn_dense_unit(const bf16* __restrict__ Qb, const bf16* __restrict__ Kh, const bf16* __restrict__ Vh,
                                                bf16* __restrict__ Ob, const float scale, char* lds, const int seqr, const float* __restrict__ ropetab) {
  constexpr int SHM_V = KVBLK * DV * 2, SHM_K = KVBLK * DK * 2, NQ = DK / 16, NKC = DK / 64;
  const float C = scale * 1.4426950408889634f, THRS = THR / scale;
  int tid_ = threadIdx.x; asm volatile("" : "+v"(tid_));
  const int tid = tid_, wid = tid >> 6, lane = tid & 63, r32 = lane & 31, hi = lane >> 5;
  char* V_lds = lds; char* K_lds = lds + 2 * SHM_V;
  float* ws = (float*)(lds + 2 * SHM_V + 2 * SHM_K) + wid * 64; float* li_l = ws; float* al_l = ws + 32;
  float m_reg = -1e30f, l_reg = 0; f32x16 o[4] = {}; bf16x8 qr[NQ];
  const bf16* Qw = Qb + (long)(wid * QBLK + r32) * ldq + hi * 8;
#pragma unroll
  for (int d0 = 0; d0 < NQ; ++d0) qr[d0] = ld8(Qw + d0 * 16);
  if constexpr (DK == 192) {
    const float* tp = ropetab + ((long)(wid * QBLK + r32) * 32 + hi * 8) * 2;
#pragma unroll
    for (int k = 0; k < 2; ++k) {
      u32x4 a = *reinterpret_cast<u32x4*>(&qr[8 + k]), b = *reinterpret_cast<u32x4*>(&qr[10 + k]); u32x4 oa, ob;
#pragma unroll
      for (int w = 0; w < 4; ++w) { const float4 t = *reinterpret_cast<const float4*>(tp + k * 32 + w * 4);
        const float x1l = __uint_as_float(a[w] << 16), x1h = __uint_as_float(a[w] & 0xffff0000u), x2l = __uint_as_float(b[w] << 16), x2h = __uint_as_float(b[w] & 0xffff0000u);
        oa[w] = cvtpk(x1l * t.x - x2l * t.y, x1h * t.z - x2h * t.w); ob[w] = cvtpk(x1l * t.y + x2l * t.x, x1h * t.w + x2h * t.z); }
      qr[8 + k] = *reinterpret_cast<bf16x8*>(&oa); qr[10 + k] = *reinterpret_cast<bf16x8*>(&ob); } }
  const int sr = tid >> 4, sc = (tid & 15) * 8, vst0 = v_st(sr, sc), vst1 = v_st(32 + sr, sc);
  int krow[NKC], kcol[NKC];
#pragma unroll
  for (int i = 0; i < NKC; ++i) { const int c = tid + 512 * i; krow[i] = c / (DK / 8); kcol[i] = (c % (DK / 8)) * 8; }
  const int vb0 = (int)(uintptr_t)V_lds + v_rd_base(lane);
  bf16x8 vs0, vs1, ks[NKC];
#define SLOAD(k0) do { vs0 = ld8(&Vh[(long)((k0) + sr) * ldv + sc]); vs1 = ld8(&Vh[(long)((k0) + 32 + sr) * ldv + sc]); \
    _Pragma("unroll") for (int i_ = 0; i_ < NKC; ++i_) ks[i_] = ld8(&Kh[(long)((k0) + krow[i_]) * ldk + kcol[i_]]); } while (0)
#define SWRITE(b) do { *(bf16x8*)(V_lds + (b) * SHM_V + vst0) = vs0; *(bf16x8*)(V_lds + (b) * SHM_V + vst1) = vs1; \
    _Pragma("unroll") for (int i_ = 0; i_ < NKC; ++i_) *(bf16x8*)(K_lds + (b) * SHM_K + kswz<DK>(krow[i_], kcol[i_] * 2)) = ks[i_]; } while (0)
  const int NT = seqr / KVBLK;
  SLOAD(0); SWRITE(0); __syncthreads();
  for (int j = 0; j < NT; ++j) {
    const int cb = j & 1;
    if (j + 1 < NT) SLOAD((j + 1) * KVBLK);
    SBAR();
    f32x16 p0, p1; float mn, al; bf16x8 pa0, pa1, pa2, pa3;
    qkt<DK>(p0, p1, K_lds + cb * SHM_K, qr, r32, hi);
    partialSM(p0, p1, m_reg, mn, al, C, THRS);
    if (__any(al < 1.f)) { if (hi == 0) al_l[r32] = al; asm volatile("s_waitcnt lgkmcnt(0)" ::: "memory");
#pragma unroll
      for (int d = 0; d < 4; ++d)
#pragma unroll
        for (int r = 0; r < 16; ++r) o[d][r] *= al_l[crow(r, hi)]; }
    finishSM(p0, p1, al, l_reg, pa0, pa1, pa2, pa3); SBAR();
    pv_d0(o, vb0 + cb * SHM_V, pa0, pa1, pa2, pa3);
    SBAR();
    if (j + 1 < NT) SWRITE(cb ^ 1);
    __syncthreads();
  }
  if (hi == 0) li_l[r32] = l_reg; asm volatile("s_waitcnt lgkmcnt(0)" ::: "memory");
  float rli[16];
#pragma unroll
  for (int r = 0; r < 16; ++r) rli[r] = __builtin_amdgcn_rcpf(li_l[crow(r, hi)]);
  bf16* Ow = Ob + (long)(wid * QBLK) * ldo;
#pragma unroll
  for (int r = 0; r < 16; ++r) { int orow = crow(r, hi);
#pragma unroll
    for (int d0 = 0; d0 < 4; ++d0) Ow[(long)orow * ldo + d0 * 32 + r32] = (bf16)(cvtpk(o[d0][r] * rli[r], 0.f) & 0xffffu); }
  __syncthreads();
#undef SLOAD
#undef SWRITE
}

template <int DK, int SDEPTH, int ldq, int ldk, int ldv, int ldo>
__device__ __forceinline__ void attn_dense_unit2(const bf16* __restrict__ Qb, const bf16* __restrict__ Kh, const bf16* __restrict__ Vh,
                                                bf16* __restrict__ Ob, const float scale, char* lds, const int seqr, const float* __restrict__ ropetab) {
  constexpr int SHM_V = KVBLK * DV * 2, SHM_K = KVBLK * DK * 2, NQ = DK / 16, NKC = DK / 64;
  const float C = scale * 1.4426950408889634f, THRS = THR / scale;
  int tid_ = threadIdx.x; asm volatile("" : "+v"(tid_));
  const int tid = tid_, wid = tid >> 6, lane = tid & 63, r32 = lane & 31, hi = lane >> 5;
  char* V_lds = lds; char* K_lds = lds + 2 * SHM_V;
  float* ws = (float*)(lds + 2 * SHM_V + 2 * SHM_K) + wid * 64; float* li_l = ws; float* al_l = ws + 32;
  float m_reg = -1e30f, l_reg = 0; f32x16 o[4] = {}; bf16x8 qr[NQ];
  const bf16* Qw = Qb + (long)(wid * QBLK + r32) * ldq + hi * 8;
#pragma unroll
  for (int d0 = 0; d0 < NQ; ++d0) qr[d0] = ld8(Qw + d0 * 16);
  if constexpr (DK == 192) {
    const float* tp = ropetab + ((long)(wid * QBLK + r32) * 32 + hi * 8) * 2;
#pragma unroll
    for (int k = 0; k < 2; ++k) {
      u32x4 a = *reinterpret_cast<u32x4*>(&qr[8 + k]), b = *reinterpret_cast<u32x4*>(&qr[10 + k]); u32x4 oa, ob;
#pragma unroll
      for (int w = 0; w < 4; ++w) { const float4 t = *reinterpret_cast<const float4*>(tp + k * 32 + w * 4);
        const float x1l = __uint_as_float(a[w] << 16), x1h = __uint_as_float(a[w] & 0xffff0000u), x2l = __uint_as_float(b[w] << 16), x2h = __uint_as_float(b[w] & 0xffff0000u);
        oa[w] = cvtpk(x1l * t.x - x2l * t.y, x1h * t.z - x2h * t.w); ob[w] = cvtpk(x1l * t.y + x2l * t.x, x1h * t.w + x2h * t.z); }
      qr[8 + k] = *reinterpret_cast<bf16x8*>(&oa); qr[10 + k] = *reinterpret_cast<bf16x8*>(&ob); } }
  const int sr = tid >> 4, sc = (tid & 15) * 8, vst0 = v_st(sr, sc), vst1 = v_st(32 + sr, sc);
  int krow[NKC], kcol[NKC];
#pragma unroll
  for (int i = 0; i < NKC; ++i) { const int c = tid + 512 * i; krow[i] = c / (DK / 8); kcol[i] = (c % (DK / 8)) * 8; }
  const int vb0 = (int)(uintptr_t)V_lds + v_rd_base(lane);
  struct { bf16x8 vs0, vs1, ks[NKC]; } sr_[SDEPTH];
#define SLOAD(i, k0) do { sr_[i].vs0 = ld8(&Vh[(long)((k0) + sr) * ldv + sc]); sr_[i].vs1 = ld8(&Vh[(long)((k0) + 32 + sr) * ldv + sc]); \
    _Pragma("unroll") for (int i_ = 0; i_ < NKC; ++i_) sr_[i].ks[i_] = ld8(&Kh[(long)((k0) + krow[i_]) * ldk + kcol[i_]]); } while (0)
#define SWRITE(b, i) do { *(bf16x8*)(V_lds + (b) * SHM_V + vst0) = sr_[i].vs0; *(bf16x8*)(V_lds + (b) * SHM_V + vst1) = sr_[i].vs1; \
    _Pragma("unroll") for (int i_ = 0; i_ < NKC; ++i_) *(bf16x8*)(K_lds + (b) * SHM_K + kswz<DK>(krow[i_], kcol[i_] * 2)) = sr_[i].ks[i_]; } while (0)
#define SWAIT() do { if constexpr (SDEPTH == 2) { if constexpr (NKC == 2) asm volatile("s_waitcnt vmcnt(4)" ::: "memory"); else asm volatile("s_waitcnt vmcnt(5)" ::: "memory"); } else asm volatile("s_waitcnt vmcnt(0)" ::: "memory"); } while (0)
#define RESC(a) do { if (__any((a) < 1.f)) { if (hi == 0) al_l[r32] = (a); asm volatile("s_waitcnt lgkmcnt(0)" ::: "memory"); \
    _Pragma("unroll") for (int d = 0; d < 4; ++d) _Pragma("unroll") for (int r = 0; r < 16; ++r) o[d][r] *= al_l[crow(r, hi)]; } } while (0)
  f32x16 pA0, pA1, pB0, pB1; float mnA, mnB, alA, alB; bf16x8 pa0, pa1, pa2, pa3; const int NT = seqr / KVBLK;
  constexpr int SE = 0, SO = SDEPTH - 1;
  SLOAD(SE, 0); asm volatile("s_waitcnt vmcnt(0)" ::: "memory"); SWRITE(0, SE); __syncthreads();
  qkt<DK>(pA0, pA1, K_lds, qr, r32, hi); partialSM(pA0, pA1, m_reg, mnA, alA, C, THRS);
  SLOAD(SO, KVBLK); if constexpr (SDEPTH == 2) { if (2 < NT) SLOAD(SE, 2 * KVBLK); }
  SWAIT(); SWRITE(1, SO); __syncthreads();
  for (int j = 1; j + 1 < NT; j += 2) {
    SBAR(); qkt<DK>(pB0, pB1, K_lds + SHM_K, qr, r32, hi);
    finishSM(pA0, pA1, alA, l_reg, pa0, pa1, pa2, pa3); SBAR();
    SLOAD(SO, (j + SDEPTH) * KVBLK); SBAR();
    pv_d0(o, vb0, pa0, pa1, pa2, pa3); partialSM(pB0, pB1, m_reg, mnB, alB, C, THRS);
    __syncthreads(); SWAIT(); SWRITE(0, SE);
    RESC(alB); __syncthreads();
    SBAR(); qkt<DK>(pA0, pA1, K_lds, qr, r32, hi);
    finishSM(pB0, pB1, alB, l_reg, pa0, pa1, pa2, pa3); SBAR();
    if (SDEPTH == 1 || j + 3 < NT) SLOAD(SE, (j + 1 + SDEPTH) * KVBLK); SBAR();
    pv_d0(o, vb0 + SHM_V, pa0, pa1, pa2, pa3); partialSM(pA0, pA1, m_reg, mnA, alA, C, THRS);
    __syncthreads(); SWAIT(); SWRITE(1, SO);
    RESC(alA); __syncthreads();
  }
  SBAR(); qkt<DK>(pB0, pB1, K_lds + SHM_K, qr, r32, hi);
  finishSM(pA0, pA1, alA, l_reg, pa0, pa1, pa2, pa3); SBAR();
  pv_d0(o, vb0, pa0, pa1, pa2, pa3); partialSM(pB0, pB1, m_reg, mnB, alB, C, THRS);
  __syncthreads(); RESC(alB);
  finishSM(pB0, pB1, alB, l_reg, pa0, pa1, pa2, pa3); SBAR();
  pv_d0(o, vb0 + SHM_V, pa0, pa1, pa2, pa3);
  if (hi == 0) li_l[r32] = l_reg; asm volatile("s_waitcnt lgkmcnt(0)" ::: "memory");
  float rli[16];
#pragma unroll
  for (int r = 0; r < 16; ++r) rli[r] = __builtin_amdgcn_rcpf(li_l[crow(r, hi)]);
  bf16* Ow = Ob + (long)(wid * QBLK) * ldo;
#pragma unroll
  for (int r = 0; r < 16; ++r) { int orow = crow(r, hi);
#pragma unroll
    for (int d0 = 0; d0 < 4; ++d0) Ow[(long)orow * ldo + d0 * 32 + r32] = (bf16)(cvtpk(o[d0][r] * rli[r], 0.f) & 0xffffu); }
  __syncthreads();
#undef SLOAD
#undef SWRITE
#undef SWAIT
#undef RESC
}

__device__ __forceinline__ void banded_wave_unit(const bf16* __restrict__ Q, long qs, const bf16* __restrict__ K, long ks, const bf16* __restrict__ V, long vs,
                                                 int i0, int L, bf16* __restrict__ O, long os, float* __restrict__ LSE, long ls, char* wlds) {
  constexpr float SCALE = 0.088388347648318440f, C = SCALE * 1.4426950408889634f;
  int tid_ = threadIdx.x; asm volatile("" : "+v"(tid_));
  const int lane = tid_ & 63, r32 = lane & 31, hi = lane >> 5;
  float* ex = (float*)(wlds + 8192);
  const int vb = (int)(uintptr_t)wlds + v_rd_base(lane);
  bf16x8 qr[8];
  { const bf16* Qw = Q + (long)(i0 + r32) * qs + hi * 8;
#pragma unroll
    for (int d0 = 0; d0 < 8; ++d0) qr[d0] = ld8(Qw + d0 * 16); }
  float m_reg = -1e30f, l_reg = 0.f; f32x16 o[4] = {};
  for (int tt = -2; tt <= 2; ++tt) {
    const int j0 = i0 + 32 * tt;
    if (j0 < 0 || j0 >= L) continue;
    bf16x8 vr[8], kf[8];
#pragma unroll
    for (int i = 0; i < 8; ++i) { const int idx = lane + 64 * i; vr[i] = ld8(V + (long)(j0 + (idx >> 4)) * vs + (idx & 15) * 8); }
    { const bf16* Kw = K + (long)(j0 + r32) * ks + hi * 8;
#pragma unroll
      for (int d0 = 0; d0 < 8; ++d0) kf[d0] = ld8(Kw + d0 * 16); }
    f32x16 p = f32x16{};
#pragma unroll
    for (int d0 = 0; d0 < 8; ++d0) p = __builtin_amdgcn_mfma_f32_32x32x16_bf16(kf[d0], qr[d0], p, 0, 0, 0);
    if (tt == -2) {
#pragma unroll
      for (int r = 0; r < 16; ++r) if (crow(r, hi) < r32) p[r] = -INFINITY; }
    if (tt == 2) {
#pragma unroll
      for (int r = 0; r < 16; ++r) if (crow(r, hi) > r32) p[r] = -INFINITY; }
    float pmax = p[0];
#pragma unroll
    for (int r = 1; r < 16; ++r) pmax = fmaxf(pmax, p[r]);
    { auto rr = __builtin_amdgcn_permlane32_swap(__float_as_uint(pmax), __float_as_uint(pmax), false, false);
      pmax = fmaxf(__uint_as_float(rr[0]), __uint_as_float(rr[1])); }
    const float mn = fmaxf(m_reg, pmax), alpha = __builtin_amdgcn_exp2f((m_reg - mn) * C); m_reg = mn;
    const float mnC = -mn * C; float ps = 0.f;
#pragma unroll
    for (int r = 0; r < 16; ++r) { p[r] = __builtin_amdgcn_exp2f(fmaf(p[r], C, mnC)); ps += p[r]; }
    { auto rr = __builtin_amdgcn_permlane32_swap(__float_as_uint(ps), __float_as_uint(ps), false, false);
      ps = __uint_as_float(rr[0]) + __uint_as_float(rr[1]); }
    l_reg = l_reg * alpha + ps;
    bf16x8 pa0, pa1; PK4(p, 0, pa0); PK4(p, 8, pa1);
    if (hi == 0) ex[r32] = alpha;
#pragma unroll
    for (int i = 0; i < 8; ++i) { const int idx = lane + 64 * i; *(bf16x8*)(wlds + v_st(idx >> 4, (idx & 15) * 8)) = vr[i]; }
    asm volatile("s_waitcnt lgkmcnt(0)" ::: "memory"); SBAR();
#pragma unroll
    for (int d = 0; d < 4; ++d)
#pragma unroll
      for (int r = 0; r < 16; ++r) o[d][r] *= ex[crow(r, hi)];
#define PV2(D0) do { const s16x4 l0 = tr_read<v_rd_off(D0, 0, 0)>(vb), h0 = tr_read<v_rd_off(D0, 0, 1)>(vb), l1 = tr_read<v_rd_off(D0, 1, 0)>(vb), h1 = tr_read<v_rd_off(D0, 1, 1)>(vb); \
      asm volatile("s_waitcnt lgkmcnt(0)" ::: "memory"); SBAR(); \
      o[D0] = __builtin_amdgcn_mfma_f32_32x32x16_bf16(pa0, PKV(l0, h0), o[D0], 0, 0, 0); \
      o[D0] = __builtin_amdgcn_mfma_f32_32x32x16_bf16(pa1, PKV(l1, h1), o[D0], 0, 0, 0); } while (0)
    PV2(0); PV2(1); PV2(2); PV2(3);
#undef PV2
    asm volatile("s_waitcnt lgkmcnt(0)" ::: "memory"); SBAR();
  }
  if (hi == 0) { ex[32 + r32] = l_reg; LSE[(long)(i0 + r32) * ls] = m_reg * SCALE + __logf(l_reg); }
  asm volatile("s_waitcnt lgkmcnt(0)" ::: "memory"); SBAR();
  float rli[16];
#pragma unroll
  for (int r = 0; r < 16; ++r) rli[r] = __builtin_amdgcn_rcpf(ex[32 + crow(r, hi)]);
#pragma unroll
  for (int r = 0; r < 16; ++r) { const int orow = crow(r, hi);
#pragma unroll
    for (int d0 = 0; d0 < 4; ++d0) O[(long)(i0 + orow) * os + d0 * 32 + r32] = (bf16)(cvtpk(o[d0][r] * rli[r], 0.f) & 0xffffu); }
  asm volatile("s_waitcnt lgkmcnt(0)" ::: "memory"); SBAR();
}
#undef PK4
#undef PKV
#undef SBAR
}
#define LAS __attribute__((address_space(3)))
typedef unsigned short bf16;
typedef unsigned v4u __attribute__((ext_vector_type(4)));
typedef unsigned v2u __attribute__((ext_vector_type(2)));
typedef float f32x4 __attribute__((ext_vector_type(4)));

constexpr int NB = 4, SEQ = 2048, T = NB * SEQ, DM = 2048, DEPTH = 2;
constexpr int NIN = 4928, NINP = 5120, NUQ = 1152, NUQP = 1280, NUKV = 1536, DFF = 5632, NUP = 2 * DFF, CQR = 512;
constexpr int AQ_OFF = 0, AK_OFF = 768, AV_OFF = 1024, BQ_OFF = 1280, BK_OFF = 2816, BV_OFF = 3328, CQ_OFF = 3840, CKV_OFF = 4352, CKR_OFF = 4864;
constexpr float EPS = 1e-6f;
constexpr int NWAVES = 8, NTHR = 512;
constexpr int LDS_BYTES = 147456;

constexpr size_t MiB = 1u << 20;
constexpr size_t SZ_WIN = (size_t)NINP * DM * 2, SZ_WUQ = (size_t)NUQP * CQR * 2, SZ_WUKV = (size_t)NUKV * CQR * 2, SZ_WOUT = (size_t)DM * DM * 2, SZ_WUP = (size_t)NUP * DM * 2, SZ_WDN = (size_t)DM * DFF * 2;
constexpr size_t WL_IN = 0, WL_UQ = WL_IN + SZ_WIN, WL_UKV = WL_UQ + SZ_WUQ, WL_OUT = WL_UKV + SZ_WUKV, WL_UP = WL_OUT + SZ_WOUT, WL_DN = WL_UP + SZ_WUP, WL_SIZE = WL_DN + SZ_WDN;
constexpr size_t WS_TAB = 1 * MiB;
constexpr int TAB_ROW = 0, TAB_COL = 32 * 32, TAB_PART = TAB_COL + 64 * 32, TAB_MLA = TAB_PART + SEQ * 16, TAB_N = TAB_MLA + SEQ * 32;
constexpr size_t WS_W = 2 * MiB;
constexpr size_t CTL_ZERO_BYTES = 65536;
constexpr int CW_BAR = 1024, LDS_MISC_OFF = 131072 + 1024, LDS_ARG_OFF = 131072 + 512;
constexpr size_t WS_XN = WS_W + 2 * WL_SIZE;
constexpr size_t WS_X = WS_XN + (size_t)T * DM * 2;
constexpr size_t WS_R1 = WS_X + (size_t)T * DM * 4;
constexpr size_t WS_PROJ = WS_R1;
constexpr size_t WS_QC = WS_PROJ + (size_t)T * NINP * 2;
constexpr size_t WS_KC = WS_QC + (size_t)T * NUQ * 2;
constexpr size_t WS_VC = WS_KC + (size_t)T * NUQ * 2;
constexpr size_t WS_OB = WS_VC + (size_t)T * 768 * 2;
constexpr size_t WS_LSE = WS_OB + (size_t)3 * T * 512 * 4;
constexpr size_t WS_R1_END = WS_LSE + (size_t)3 * T * 4 * 4;
constexpr size_t WS_H = WS_R1;
constexpr size_t WS_H_END = WS_H + (size_t)T * NUP * 2;
constexpr size_t WS_R2 = (WS_R1_END > WS_H_END ? WS_R1_END : WS_H_END);
constexpr size_t WS_Y = WS_R2;
constexpr size_t WS_YN = WS_Y + (size_t)T * DM * 4;
constexpr size_t WS_ACT = WS_R2;
constexpr size_t WS_X2 = WS_YN + (size_t)T * DM * 2;
constexpr size_t WS_HB = WS_X2 + (size_t)T * DM * 4;
constexpr size_t WS_END = WS_HB + (size_t)(T / 256) * 4 * NUP * 4;
static_assert((size_t)T * DFF * 2 <= (size_t)T * DM * 6, "ACT fits over Y|YN");
static_assert((size_t)TAB_N * 8 <= MiB, "tables fit");
static_assert(WS_W % 256 == 0 && WL_SIZE % 256 == 0 && WS_R2 % 256 == 0, "alignment");

struct Args {
    const float *x, *attn_norm, *w_in, *a_q_norm, *a_k_norm, *c_q_norm, *c_kv_norm, *w_uq, *w_ukv, *out_norm, *w_out, *ffn_norm, *w_up, *conv_w, *conv_b, *w_down, *final_norm;
    float* out; unsigned char* ws; int ph_lo, ph_hi;
};

__device__ __forceinline__ unsigned f2bf(float f) { unsigned u = __builtin_bit_cast(unsigned, f); return (u + 0x7fffu + ((u >> 16) & 1u)) >> 16; }
__device__ __forceinline__ unsigned pk2(float lo, float hi) { return f2bf(lo) | (f2bf(hi) << 16); }
__device__ __forceinline__ float bf2f(unsigned short h) { return __builtin_bit_cast(float, (unsigned)h << 16); }
__device__ __forceinline__ float bflo(unsigned w) { return __builtin_bit_cast(float, w << 16); }
__device__ __forceinline__ float bfhi(unsigned w) { return __builtin_bit_cast(float, w & 0xffff0000u); }
__device__ __forceinline__ float wave_sum(float v) {
#pragma unroll
    for (int o = 1; o < 64; o <<= 1) v += __shfl_xor(v, o);
    return v;
}

template <bool FFN_PERM = false>
__device__ __forceinline__ void p0_transpose_item(const float* W, int K, int N, bf16* WT, float*  , int item, int lane) {
    const int nblk = N / 64, kb0 = item / nblk, nb = item % nblk, k0 = 64 * kb0, n0 = 64 * nb, kb = lane >> 4, nq = lane & 15;
    const int d0 = FFN_PERM ? (256 * ((n0 % DFF) / 128) + 128 * (n0 / DFF) + (n0 % DFF) % 128) : n0;
    const float* src = W + (size_t)(k0 + 8 * kb) * N + n0 + 4 * nq;
    bf16* dst = WT + (size_t)(d0 + 4 * nq) * K + k0 + 8 * kb;
#pragma unroll
    for (int h = 0; h < 2; ++h) {
        f32x4 v[8];
#pragma unroll
        for (int j = 0; j < 8; ++j) v[j] = __builtin_nontemporal_load((const f32x4*)(src + (size_t)(32 * h + j) * N));
#pragma unroll
        for (int i = 0; i < 4; ++i) { v4u o; o.x = pk2(v[0][i], v[1][i]); o.y = pk2(v[2][i], v[3][i]); o.z = pk2(v[4][i], v[5][i]); o.w = pk2(v[6][i], v[7][i]);
            *(v4u*)(dst + (size_t)i * K + 32 * h) = o; }
    }
}
__device__ __forceinline__ void rms_row_bf16(const float* xrow, const float* g, bf16* orow, int lane) {
    const f32x4* xr = (const f32x4*)xrow + lane; const f32x4* gr = (const f32x4*)g + lane;
    f32x4 v[8]; float s = 0.f;
#pragma unroll
    for (int j = 0; j < 8; ++j) { v[j] = __builtin_nontemporal_load(xr + 64 * j); s += (v[j].x * v[j].x + v[j].y * v[j].y) + (v[j].z * v[j].z + v[j].w * v[j].w); }
    const float rstd = 1.f / sqrtf(wave_sum(s) * (1.f / DM) + EPS);
    v2u* o8 = (v2u*)orow + lane;
#pragma unroll
    for (int j = 0; j < 8; ++j) { const f32x4 gg = gr[64 * j]; v2u w; w.x = pk2(v[j].x * rstd * gg.x, v[j].y * rstd * gg.y); w.y = pk2(v[j].z * rstd * gg.z, v[j].w * rstd * gg.w); o8[64 * j] = w; }
}
__device__ __forceinline__ void rms_row_f32(const float* xrow, const float* g, float* orow, int lane) {
    const f32x4* xr = (const f32x4*)xrow + lane; const f32x4* gr = (const f32x4*)g + lane;
    f32x4 v[8]; float s = 0.f;
#pragma unroll
    for (int j = 0; j < 8; ++j) { v[j] = xr[64 * j]; s += (v[j].x * v[j].x + v[j].y * v[j].y) + (v[j].z * v[j].z + v[j].w * v[j].w); }
    const float rstd = 1.f / sqrtf(wave_sum(s) * (1.f / DM) + EPS);
    f32x4* o = (f32x4*)orow + lane;
#pragma unroll
    for (int j = 0; j < 8; ++j) { const f32x4 gg = gr[64 * j]; o[64 * j] = v[j] * rstd * gg; }
}
__device__ __forceinline__ void rmsb_row(const bf16* xrow, const float* g, bf16* obf, float* of32, int lane) {
    const v4u* xr = (const v4u*)xrow + lane; float f[4][8]; float s = 0.f;
#pragma unroll
    for (int j = 0; j < 4; ++j) { const v4u r = xr[64 * j]; f[j][0] = bflo(r.x); f[j][1] = bfhi(r.x); f[j][2] = bflo(r.y); f[j][3] = bfhi(r.y); f[j][4] = bflo(r.z); f[j][5] = bfhi(r.z); f[j][6] = bflo(r.w); f[j][7] = bfhi(r.w);
#pragma unroll
        for (int e = 0; e < 8; ++e) s += f[j][e] * f[j][e]; }
    const float rstd = 1.f / sqrtf(wave_sum(s) * (1.f / DM) + EPS);
#pragma unroll
    for (int j = 0; j < 4; ++j) { const int c = (lane + 64 * j) * 8; const f32x4 g0 = *(const f32x4*)(g + c), g1 = *(const f32x4*)(g + c + 4);
        const float y0 = f[j][0] * rstd * g0.x, y1 = f[j][1] * rstd * g0.y, y2 = f[j][2] * rstd * g0.z, y3 = f[j][3] * rstd * g0.w, y4 = f[j][4] * rstd * g1.x, y5 = f[j][5] * rstd * g1.y, y6 = f[j][6] * rstd * g1.z, y7 = f[j][7] * rstd * g1.w;
        if (obf) { v4u w; w.x = pk2(y0, y1); w.y = pk2(y2, y3); w.z = pk2(y4, y5); w.w = pk2(y6, y7); *(v4u*)(obf + c) = w; }
        else { __builtin_nontemporal_store((f32x4){y0, y1, y2, y3}, (f32x4*)(of32 + c)); __builtin_nontemporal_store((f32x4){y4, y5, y6, y7}, (f32x4*)(of32 + c + 4)); } }
}
__device__ __forceinline__ float inv_freq(float theta, int j2, int dim) { return powf(theta, -(float)j2 / (float)dim); }

__device__ __forceinline__ void unpack8(const v4u r, float* f) { f[0] = bflo(r.x); f[1] = bfhi(r.x); f[2] = bflo(r.y); f[3] = bfhi(r.y); f[4] = bflo(r.z); f[5] = bfhi(r.z); f[6] = bflo(r.w); f[7] = bfhi(r.w); }
typedef float f32x2 __attribute__((ext_vector_type(2)));
__device__ __forceinline__ v4u rope8(const float* y, const float* yp, bool first, const f32x2* cs) {
    float o[8];
#pragma unroll
    for (int e = 0; e < 8; ++e) { const f32x2 t = cs[e]; o[e] = first ? (y[e] * t.x - yp[e] * t.y) : (yp[e] * t.y + y[e] * t.x); }
    v4u w; w.x = pk2(o[0], o[1]); w.y = pk2(o[2], o[3]); w.z = pk2(o[4], o[5]); w.w = pk2(o[6], o[7]); return w;
}
__device__ __forceinline__ void prep_row(bf16* P, bf16* KCrow, int s, const float* aqn, const float* akn, const float* cqn, const float* ckvn, const f32x2* tab, int lane) {
    { const int l16 = lane & 15, hsel = lane >> 4; const bool first = (l16 & 4) == 0;
      const f32x2* cs = tab + ((l16 < 8) ? (TAB_ROW + (s / 64) * 32) : (TAB_COL + (s % 64) * 32)) + (l16 & 3) * 8;
#pragma unroll
      for (int it = 0; it < 2; ++it) { const int hh = it * 4 + hsel; bf16* hp = P + AQ_OFF + hh * 128 + l16 * 8; const float* g = ((hh < 6) ? aqn : akn) + l16 * 8;
          float f[8], y[8], yp[8]; unpack8(*(const v4u*)hp, f);
          float ss = 0.f;
#pragma unroll
          for (int e = 0; e < 8; ++e) ss += f[e] * f[e];
          ss += __shfl_xor(ss, 1); ss += __shfl_xor(ss, 2); ss += __shfl_xor(ss, 4); ss += __shfl_xor(ss, 8);
          const float rstd = 1.f / sqrtf(ss * (1.f / 128.f) + EPS);
#pragma unroll
          for (int e = 0; e < 8; ++e) { y[e] = f[e] * rstd * g[e]; yp[e] = __shfl_xor(y[e], 4); }
          *(v4u*)hp = rope8(y, yp, first, cs); } }
    { const int hh = lane >> 2, cq = lane & 3; const bool first = cq < 2; bf16* hp = P + BQ_OFF + hh * 128 + cq * 8;
      const f32x2* cs = tab + TAB_PART + s * 16 + (cq & 1) * 8;
      float y[8], yp[8]; unpack8(*(const v4u*)hp, y);
#pragma unroll
      for (int e = 0; e < 8; ++e) yp[e] = __shfl_xor(y[e], 2);
      *(v4u*)hp = rope8(y, yp, first, cs); }
#pragma unroll
    for (int w = 0; w < 2; ++w) { bf16* lp = P + (w == 0 ? CQ_OFF : CKV_OFF) + lane * 8; const float* g = (w == 0 ? cqn : ckvn) + lane * 8;
        float f[8]; unpack8(*(const v4u*)lp, f);
        float ss = 0.f;
#pragma unroll
        for (int e = 0; e < 8; ++e) ss += f[e] * f[e];
        const float rstd = 1.f / sqrtf(wave_sum(ss) * (1.f / 512.f) + EPS);
        v4u o; o.x = pk2(f[0] * rstd * g[0], f[1] * rstd * g[1]); o.y = pk2(f[2] * rstd * g[2], f[3] * rstd * g[3]); o.z = pk2(f[4] * rstd * g[4], f[5] * rstd * g[5]); o.w = pk2(f[6] * rstd * g[6], f[7] * rstd * g[7]);
        *(v4u*)lp = o; }
    { const int l8 = lane & 7; const bool first = l8 < 4; bf16* kp = P + CKR_OFF + l8 * 8; const f32x2* cs = tab + TAB_MLA + s * 32 + (l8 & 3) * 8;
      float y[8], yp[8]; unpack8(*(const v4u*)kp, y);
#pragma unroll
      for (int e = 0; e < 8; ++e) yp[e] = __shfl_xor(y[e], 4);
      const v4u w = rope8(y, yp, first, cs);
      if (lane < 8) { *(v4u*)kp = w;
#pragma unroll
          for (int h = 0; h < 6; ++h) *(v4u*)(KCrow + h * 192 + 128 + l8 * 8) = w; } }
}
__device__ __forceinline__ f32x4 ldbf4(const bf16* p) { const v2u r = *(const v2u*)p; return (f32x4){bflo(r.x), bfhi(r.x), bflo(r.y), bfhi(r.y)}; }
__device__ __forceinline__ void outnorm_row(const bf16* Yrow, const bf16* OB, const float* LSE, int t, const float* g, bf16* YNrow, int lane) {
    f32x4 a[3], c[3], b[2];
    float sa = 0.f, sb = 0.f, scc = 0.f;
#pragma unroll
    for (int k = 0; k < 3; ++k) { a[k] = ldbf4(Yrow + (lane + 64 * k) * 4); sa += (a[k].x * a[k].x + a[k].y * a[k].y) + (a[k].z * a[k].z + a[k].w * a[k].w);
                                  c[k] = ldbf4(Yrow + 1280 + (lane + 64 * k) * 4); scc += (c[k].x * c[k].x + c[k].y * c[k].y) + (c[k].z * c[k].z + c[k].w * c[k].w); }
#pragma unroll
    for (int k = 0; k < 2; ++k) { const int idx = lane + 64 * k, h = idx >> 5;
        const float l0 = LSE[((size_t)0 * T + t) * 4 + h], l1 = LSE[((size_t)1 * T + t) * 4 + h], l2 = LSE[((size_t)2 * T + t) * 4 + h];
        const float mx = fmaxf(l0, fmaxf(l1, l2)); const float e0 = __expf(l0 - mx), e1 = __expf(l1 - mx), e2 = __expf(l2 - mx); const float inv = 1.f / (e0 + e1 + e2);
        const f32x4 o0 = ldbf4(OB + ((size_t)0 * T + t) * 512 + idx * 4), o1 = ldbf4(OB + ((size_t)1 * T + t) * 512 + idx * 4), o2 = ldbf4(OB + ((size_t)2 * T + t) * 512 + idx * 4);
        b[k] = o0 * (e0 * inv) + o1 * (e1 * inv) + o2 * (e2 * inv);
        sb += (b[k].x * b[k].x + b[k].y * b[k].y) + (b[k].z * b[k].z + b[k].w * b[k].w); }
    const float ra = 1.f / sqrtf(wave_sum(sa) * (1.f / 768.f) + EPS), rb = 1.f / sqrtf(wave_sum(sb) * (1.f / 512.f) + EPS), rc = 1.f / sqrtf(wave_sum(scc) * (1.f / 768.f) + EPS);
#pragma unroll
    for (int k = 0; k < 3; ++k) { const int idx = lane + 64 * k; const f32x4 ga = ((const f32x4*)g)[idx], gc = ((const f32x4*)(g + 1280))[idx];
        v2u w; w.x = pk2(a[k].x * ra * ga.x, a[k].y * ra * ga.y); w.y = pk2(a[k].z * ra * ga.z, a[k].w * ra * ga.w); ((v2u*)YNrow)[idx] = w;
        v2u w2; w2.x = pk2(c[k].x * rc * gc.x, c[k].y * rc * gc.y); w2.y = pk2(c[k].z * rc * gc.z, c[k].w * rc * gc.w); ((v2u*)(YNrow + 1280))[idx] = w2; }
#pragma unroll
    for (int k = 0; k < 2; ++k) { const int idx = lane + 64 * k; const f32x4 gb = ((const f32x4*)(g + 768))[idx];
        v2u w; w.x = pk2(b[k].x * rb * gb.x, b[k].y * rb * gb.y); w.y = pk2(b[k].z * rb * gb.z, b[k].w * rb * gb.w); ((v2u*)(YNrow + 768))[idx] = w; }
}
constexpr int CONV_R = 16;
__device__ __forceinline__ void convact_item(const bf16* H, const float* cw, const float* cb, bf16* ACT, int t0, int c8) {
    const int c = c8 * 8, s0 = t0 % SEQ;
    float wg[3][8], wu[3][8], bg[8], bu[8];
#pragma unroll
    for (int k = 0; k < 3; ++k) { const f32x4 a0 = *(const f32x4*)(cw + (size_t)k * NUP + c), a1 = *(const f32x4*)(cw + (size_t)k * NUP + c + 4), b0 = *(const f32x4*)(cw + (size_t)k * NUP + DFF + c), b1 = *(const f32x4*)(cw + (size_t)k * NUP + DFF + c + 4);
        wg[k][0] = a0.x; wg[k][1] = a0.y; wg[k][2] = a0.z; wg[k][3] = a0.w; wg[k][4] = a1.x; wg[k][5] = a1.y; wg[k][6] = a1.z; wg[k][7] = a1.w;
        wu[k][0] = b0.x; wu[k][1] = b0.y; wu[k][2] = b0.z; wu[k][3] = b0.w; wu[k][4] = b1.x; wu[k][5] = b1.y; wu[k][6] = b1.z; wu[k][7] = b1.w; }
    { const f32x4 a0 = *(const f32x4*)(cb + c), a1 = *(const f32x4*)(cb + c + 4), b0 = *(const f32x4*)(cb + DFF + c), b1 = *(const f32x4*)(cb + DFF + c + 4);
      bg[0] = a0.x; bg[1] = a0.y; bg[2] = a0.z; bg[3] = a0.w; bg[4] = a1.x; bg[5] = a1.y; bg[6] = a1.z; bg[7] = a1.w;
      bu[0] = b0.x; bu[1] = b0.y; bu[2] = b0.z; bu[3] = b0.w; bu[4] = b1.x; bu[5] = b1.y; bu[6] = b1.z; bu[7] = b1.w; }
    const bf16* hp = H + (size_t)t0 * NUP + c;
    v4u pg, pu, cg_, cu, ng, nu;
    const v4u z = (v4u){0u, 0u, 0u, 0u};
    if (s0 > 0) { pg = *(const v4u*)(hp - NUP); pu = *(const v4u*)(hp - NUP + DFF); } else { pg = z; pu = z; }
    cg_ = *(const v4u*)hp; cu = *(const v4u*)(hp + DFF);
#pragma unroll 4
    for (int r = 0; r < CONV_R; ++r) {
        if (s0 + r + 1 < SEQ) { ng = *(const v4u*)(hp + (size_t)(r + 1) * NUP); nu = *(const v4u*)(hp + (size_t)(r + 1) * NUP + DFF); } else { ng = z; nu = z; }
        float a0[8], a1[8], a2[8], b0[8], b1[8], b2[8], o[8];
        unpack8(pg, a0); unpack8(cg_, a1); unpack8(ng, a2); unpack8(pu, b0); unpack8(cu, b1); unpack8(nu, b2);
#pragma unroll
        for (int e = 0; e < 8; ++e) { const float g = bg[e] + wg[0][e] * a0[e] + wg[1][e] * a1[e] + wg[2][e] * a2[e], u = bu[e] + wu[0][e] * b0[e] + wu[1][e] * b1[e] + wu[2][e] * b2[e];
            o[e] = g / (1.f + __expf(-g)) * u; }
        v4u w; w.x = pk2(o[0], o[1]); w.y = pk2(o[2], o[3]); w.z = pk2(o[4], o[5]); w.w = pk2(o[6], o[7]);
        *(v4u*)(ACT + (size_t)(t0 + r) * DFF + c) = w;
        pg = cg_; pu = cu; cg_ = ng; cu = nu;
    }
}

#define XB_TMO      128
#define XB_XCNT(j)  (256  + 64 * (j))
#define XB_XSUB(j)  (1280 + 64 * (j))
#define XB_XGEN(j)  (2304 + 64 * (j))
#define XB_TOP      3328
#define XB_TOPGEN   3392
#define XCD_BAR_WORDS 3456
#define XB_SPIN_CAP (1u << 18)

__device__ __forceinline__ unsigned xb_ld(unsigned* p)              { return __hip_atomic_load(p, __ATOMIC_RELAXED, __HIP_MEMORY_SCOPE_AGENT); }
__device__ __forceinline__ unsigned xb_add(unsigned* p, unsigned v) { return __hip_atomic_fetch_add(p, v, __ATOMIC_RELAXED, __HIP_MEMORY_SCOPE_AGENT); }
__device__ __forceinline__ unsigned xb_xcc_id() { return (unsigned)__builtin_amdgcn_s_getreg((3 << 11) | 20) & 0xFu; }
#define XB_SPIN(cond, bar) do { unsigned _sp = 0; while (cond) { __builtin_amdgcn_s_sleep(1); \
    if ((++_sp & 255u) == 0u) { if (xb_ld(&(bar)[XB_TMO])) break; if (_sp > XB_SPIN_CAP) { atomicAdd(&(bar)[XB_TMO], 1u); break; } } } } while (0)

struct XcdBarrier {
    unsigned* bar; unsigned x;
    volatile LAS unsigned* st;
};

__device__ __forceinline__ XcdBarrier xcd_barrier_post(unsigned* bar, volatile LAS unsigned* st) {
    XcdBarrier b; b.bar = bar; b.x = xb_xcc_id(); b.st = st;
    if (threadIdx.x == 0) (void)xb_add(&bar[XB_XCNT(b.x)], 1u);
    return b;
}
__device__ __forceinline__ void xcd_barrier_complete(unsigned* bar, unsigned x, unsigned& nloc, unsigned& nx) {
    const unsigned G = gridDim.x * gridDim.y * gridDim.z;
    unsigned sum, cnt, mine, sp = 0u;
    for (;;) {
        sum = 0u; cnt = 0u; mine = 0u;
#pragma unroll
        for (unsigned j = 0; j < 16; ++j) { const unsigned c = xb_ld(&bar[XB_XCNT(j)]); sum += c; cnt += (c > 0u) ? 1u : 0u; mine = (j == x) ? c : mine; }
        if (sum == G) break;
        __builtin_amdgcn_s_sleep(1);
        if ((++sp & 255u) == 0u) { if (xb_ld(&bar[XB_TMO])) break; if (sp > XB_SPIN_CAP) { atomicAdd(&bar[XB_TMO], 1u); break; } }
    }
    nloc = mine > 0u ? mine : 1u; nx = cnt > 0u ? cnt : 1u;
}

__device__ __forceinline__ void xcd_barrier(const XcdBarrier& b) {
    asm volatile("s_waitcnt vmcnt(0)" ::: "memory");
    __syncthreads();
    if (threadIdx.x == 0) {
        unsigned* bar = b.bar;
        __builtin_amdgcn_s_waitcnt(0);
        unsigned nloc = b.st[0], nx = b.st[1];
        if (nloc == 0u) { xcd_barrier_complete(bar, b.x, nloc, nx); b.st[0] = nloc; b.st[1] = nx; }
        const unsigned old = xb_add(&bar[XB_XSUB(b.x)], 1u);
        const unsigned gen = old / nloc;
        if (old + 1u == (gen + 1u) * nloc) {
            __builtin_amdgcn_fence(__ATOMIC_RELEASE, "agent");
            asm volatile("s_waitcnt vmcnt(0)" ::: "memory");
            const unsigned og = xb_add(&bar[XB_TOP], 1u);
            const unsigned tg = og / nx;
            if (og + 1u == (tg + 1u) * nx) xb_add(&bar[XB_TOPGEN], 1u);
            else XB_SPIN(xb_ld(&bar[XB_TOPGEN]) == tg, bar);
            __builtin_amdgcn_fence(__ATOMIC_ACQUIRE, "agent");
            xb_add(&bar[XB_XGEN(b.x)], 1u);
            asm volatile("s_waitcnt vmcnt(0)" ::: "memory");
        } else {
            XB_SPIN(xb_ld(&bar[XB_XGEN(b.x)]) == gen, bar);
            __builtin_amdgcn_fence(__ATOMIC_ACQUIRE, "agent");
            asm volatile("s_waitcnt vmcnt(0)" ::: "memory");
        }
    }
    __syncthreads();
}

__device__ __forceinline__ const float* ldarg(const LAS unsigned long long* t, int i) { const unsigned long long v = t[i];
    const unsigned lo = __builtin_amdgcn_readfirstlane((unsigned)v), hi = __builtin_amdgcn_readfirstlane((unsigned)(v >> 32)); return (const float*)(((unsigned long long)hi << 32) | lo); }
constexpr int NPL = 11, NPLX = NPL + 1, NPH = NPLX * DEPTH;
#ifndef USE_CG_SYNC
#define GRID_BAR() xcd_barrier(xbar)
#else
#define GRID_BAR() grid.sync()
#endif
#ifndef PH_MASK
#define PH_MASK 0xffff
#endif
#define PH_EN(k) (((PH_MASK) >> (k)) & 1)
#ifndef ATT_MASK
#define ATT_MASK 15
#endif
#ifndef SD128
#define SD128 2
#endif
#ifndef SD192
#define SD192 1
#endif
#ifndef NQR128
#define NQR128 4
#endif
#ifndef NQR192
#define NQR192 4
#endif
#ifndef ATTV128
#define ATTV128 0
#endif
#ifndef ATTV192
#define ATTV192 0
#endif
#if ATTV128 == 0
#define ATTN128 att::attn_dense_unit<128, NINP, NINP, NINP, DM>
#else
#define ATTN128 att::attn_dense_unit2<128, ATTV128, NINP, NINP, NINP, DM>
#endif
#if ATTV192 == 0
#define ATTN192 att::attn_dense_unit<192, NUQ, NUQ, 768, DM>
#else
#define ATTN192 att::attn_dense_unit2<192, ATTV192, NUQ, NUQ, 768, DM>
#endif
#define ATT_EN(k) (((amask) >> (k)) & 1)

__global__ void __launch_bounds__(NTHR, 2) fwd(Args a) {
    extern __shared__ __attribute__((aligned(16))) unsigned char lds[];
    cg::grid_group grid = cg::this_grid();
    { volatile LAS unsigned long long* at = (volatile LAS unsigned long long*)((LAS unsigned char*)lds + LDS_ARG_OFF);
      if (threadIdx.x == 0) { at[0] = (unsigned long long)a.x; at[1] = (unsigned long long)a.attn_norm; at[2] = (unsigned long long)a.w_in; at[3] = (unsigned long long)a.a_q_norm; at[4] = (unsigned long long)a.a_k_norm;
          at[5] = (unsigned long long)a.c_q_norm; at[6] = (unsigned long long)a.c_kv_norm; at[7] = (unsigned long long)a.w_uq; at[8] = (unsigned long long)a.w_ukv; at[9] = (unsigned long long)a.out_norm;
          at[10] = (unsigned long long)a.w_out; at[11] = (unsigned long long)a.ffn_norm; at[12] = (unsigned long long)a.w_up; at[13] = (unsigned long long)a.conv_w; at[14] = (unsigned long long)a.conv_b;
          at[15] = (unsigned long long)a.w_down; at[16] = (unsigned long long)a.final_norm; at[17] = (unsigned long long)a.out; at[18] = (unsigned long long)a.ws; } }
#define AP(i) ldarg((const LAS unsigned long long*)((LAS unsigned char*)lds + LDS_ARG_OFF), (i))
    const int G = gridDim.x, bx = blockIdx.x;
    const int NGW = G * NWAVES;
#define XN ((bf16*)(ws + WS_XN))
#define X ((bf16*)(ws + WS_X))
#define X2 ((bf16*)(ws + WS_X2))
#define PROJ ((bf16*)(ws + WS_PROJ))
#define QC ((bf16*)(ws + WS_QC))
#define KC ((bf16*)(ws + WS_KC))
#define VC ((bf16*)(ws + WS_VC))
#define OB ((bf16*)(ws + WS_OB))
#define LSE ((float*)(ws + WS_LSE))
#define H ((bf16*)(ws + WS_H))
#define Y ((bf16*)(ws + WS_Y))
#define YN ((bf16*)(ws + WS_YN))
#define ACT ((bf16*)(ws + WS_ACT))

    volatile LAS unsigned* xst = (volatile LAS unsigned*)((LAS unsigned char*)lds + LDS_MISC_OFF);
    if (threadIdx.x < 4) xst[threadIdx.x] = 0u;
    __syncthreads();
    XcdBarrier xbar = xcd_barrier_post((unsigned*)a.ws + CW_BAR, xst);
    if (a.ph_lo < 0) grid.sync();
#ifdef DIAG_A
    if (bx == 0 && threadIdx.x == 0) ((unsigned long long*)ws)[16 + a.ph_lo] = __builtin_amdgcn_s_memrealtime();
#endif
#ifdef REP_PH
    constexpr int REP_LEN = REP_PH2 - REP_PH + 1, REP_X = REP_N * REP_LEN;
    for (int it_ = a.ph_lo; it_ < a.ph_hi + REP_X; ++it_) { const int ph = (it_ <= REP_PH2) ? it_ : ((it_ <= REP_PH2 + REP_X) ? REP_PH + (it_ - REP_PH2 - 1) % REP_LEN : it_ - REP_X);
#else
    for (int ph = a.ph_lo; ph < a.ph_hi; ++ph) {
#endif
        int tid_ = threadIdx.x; asm volatile("" : "+v"(tid_));
#if defined(REP_PH) && defined(REP_ATT_MASK)
        const int amask = (it_ > REP_PH2 && it_ <= REP_PH2 + REP_X) ? (REP_ATT_MASK) : (ATT_MASK);
#else
        const int amask = ATT_MASK;
#endif
        const int tid = tid_, lane = tid & 63, wave = __builtin_amdgcn_readfirstlane(tid >> 6);
        unsigned char* const ws = (unsigned char*)AP(18);
        const int gw = bx * NWAVES + wave;
        const int l = ph / NPLX, k = ph % NPLX - 1;
        unsigned char* wl = ws + WS_W + (size_t)l * WL_SIZE;
        if (k < 0 && PH_EN(12)) {
            float* scr = (float*)(lds + wave * 16384);
            constexpr int I_IN = (DM / 64) * (NIN / 64), I_UQ = (CQR / 64) * (NUQ / 64), I_UKV = (CQR / 64) * (NUKV / 64), I_OUT = (DM / 64) * (DM / 64), I_UP = (DM / 64) * (NUP / 64), I_DN = (DFF / 64) * (DM / 64);
            constexpr int I_L = I_IN + I_UQ + I_UKV + I_OUT + I_UP + I_DN;
            for (int it = gw; it < I_L; it += NGW) {
                const int ll = l; int r = it; unsigned char* wb = wl;
                if (r < I_IN) { p0_transpose_item(AP(2) + (size_t)ll * DM * NIN, DM, NIN, (bf16*)(wb + WL_IN), scr, r, lane); continue; } r -= I_IN;
                if (r < I_UQ) { p0_transpose_item(AP(7) + (size_t)ll * CQR * NUQ, CQR, NUQ, (bf16*)(wb + WL_UQ), scr, r, lane); continue; } r -= I_UQ;
                if (r < I_UKV) { p0_transpose_item(AP(8) + (size_t)ll * CQR * NUKV, CQR, NUKV, (bf16*)(wb + WL_UKV), scr, r, lane); continue; } r -= I_UKV;
                if (r < I_OUT) { p0_transpose_item(AP(10) + (size_t)ll * DM * DM, DM, DM, (bf16*)(wb + WL_OUT), scr, r, lane); continue; } r -= I_OUT;
                if (r < I_UP) { p0_transpose_item<true>(AP(12) + (size_t)ll * DM * NUP, DM, NUP, (bf16*)(wb + WL_UP), scr, r, lane); continue; } r -= I_UP;
                p0_transpose_item(AP(15) + (size_t)ll * DFF * DM, DFF, DM, (bf16*)(wb + WL_DN), scr, r, lane);
            }
            { unsigned char* wb = wl;
                v4u* z1 = (v4u*)(wb + WL_IN + (size_t)NIN * DM * 2); const int n1 = (NINP - NIN) * DM * 2 / 16;
                for (int i = bx * NTHR + tid; i < n1; i += G * NTHR) z1[i] = (v4u){0u, 0u, 0u, 0u};
                v4u* z2 = (v4u*)(wb + WL_UQ + (size_t)NUQ * CQR * 2); const int n2 = (NUQP - NUQ) * CQR * 2 / 16;
                for (int i = bx * NTHR + tid; i < n2; i += G * NTHR) z2[i] = (v4u){0u, 0u, 0u, 0u};
            }
            if (l == 0) { f32x2* tab = (f32x2*)(ws + WS_TAB);
              for (int i = bx * NTHR + tid; i < TAB_N; i += G * NTHR) {
                  float pos, inv;
                  if (i < TAB_COL) { pos = (float)(i / 32); inv = inv_freq(10000.f, 2 * (i % 32), 64); }
                  else if (i < TAB_PART) { const int q = i - TAB_COL; pos = (float)(q / 32); inv = inv_freq(10000.f, 2 * (q % 32), 64); }
                  else if (i < TAB_MLA) { const int q = i - TAB_PART; pos = (float)(q / 16); inv = inv_freq(500000.f, 2 * (q % 16), 32); }
                  else { const int q = i - TAB_MLA; pos = (float)(q / 32); inv = inv_freq(10000.f, 2 * (q % 32), 64); }
                  const float ang = pos * inv; tab[i] = (f32x2){cosf(ang), sinf(ang)}; } }
            if (l == 0) for (int m = gw; m < T; m += NGW) rms_row_bf16(AP(0) + (size_t)m * DM, AP(1), XN + (size_t)m * DM, lane);
        } else if (k == 0 && PH_EN(0)) {
            pg8::Gemm g{XN, (const pg8::bf16_t*)(wl + WL_IN), T, NINP, DM, DM}; pg8::StaticOrder S; S.init(T, NINP, G, bx);
            pg8::EpiBf16G<0> E{PROJ, NINP, NINP, nullptr, 0};
            pg8::gemm_phase<pg8::EpiBf16G<0>, pg8::StaticOrder, true, true>((LAS unsigned char*)lds, g, S, E);
        } else if (k == 1 && PH_EN(1)) {
            for (int m = gw; m < T; m += NGW) prep_row(PROJ + (size_t)m * NINP, KC + (size_t)m * NUQ, m % SEQ, AP(3) + l * 128, AP(4) + l * 128, AP(5) + l * CQR, AP(6) + l * CQR, (const f32x2*)(ws + WS_TAB), lane);
        } else if (k == 2 && PH_EN(2)) {
            { pg8::Gemm g{PROJ + CQ_OFF, (const pg8::bf16_t*)(wl + WL_UQ), T, NUQP, CQR, NINP}; pg8::StaticOrder S; S.init(T, NUQP, G, bx);
              pg8::EpiBf16G<0> E{QC, NUQ, NUQ, nullptr, 0};
              pg8::gemm_phase<pg8::EpiBf16G<0>, pg8::StaticOrder, true, true>((LAS unsigned char*)lds, g, S, E); }
            { pg8::Gemm g{PROJ + CKV_OFF, (const pg8::bf16_t*)(wl + WL_UKV), T, NUKV, CQR, NINP}; pg8::StaticOrder S; S.init(T, NUKV, G, bx);
              pg8::EpiBf16G<1> E{KC, NUQ, 0, VC, 768};
              pg8::gemm_phase<pg8::EpiBf16G<1>, pg8::StaticOrder, true, true>((LAS unsigned char*)lds, g, S, E); }
        } else if (k == 3 && PH_EN(3)) {
            for (int i_ = 0; i_ < 4; ++i_) {
                int u;
                if (G == 256) {
                    if (bx < 64) { if (i_ >= 2) break; u = 192 + 64 * i_ + bx; }
                    else if (bx < 128) { if (i_ >= 2) break; u = (i_ == 0) ? (bx - 64) : (192 + 128 + (bx - 64)); }
                    else { u = (i_ == 0) ? (64 + (bx - 128)) : (384 + (bx - 128) * 3 + (i_ - 1)); }
                } else { u = bx + i_ * G; if (u >= 768) break; }
                if (u < 192) { if (ATT_EN(0)) { const int b = u / 48, h = (u % 48) / 8, qb = u % 8; const size_t r0 = (size_t)b * SEQ;
                    ATTN192(QC + (r0 + qb * 256) * NUQ + h * 192, KC + r0 * NUQ + h * 192, VC + r0 * 768 + h * 128,
                                              Y + (r0 + qb * 256) * DM + 1280 + h * 128, 0.07216878364870322f, (char*)lds, a.ph_hi > 0 ? SEQ : 0, (const float*)(ws + WS_TAB) + (size_t)2 * (TAB_MLA + qb * 256 * 32));
                } } else if (u < 384) { if (ATT_EN(1)) { const int v = u - 192, b = v / 48, h = (v % 48) / 8, qb = v % 8, kvh = h / 3; const size_t r0 = (size_t)b * SEQ;
                    ATTN128(PROJ + (r0 + qb * 256) * NINP + AQ_OFF + h * 128, PROJ + r0 * NINP + AK_OFF + kvh * 128, PROJ + r0 * NINP + AV_OFF + kvh * 128,
                                              Y + (r0 + qb * 256) * DM + h * 128, 0.088388347648318440f, (char*)lds, a.ph_hi > 0 ? SEQ : 0, nullptr);
                } } else { if (ATT_EN(2)) { const int wu = (u - 384) * 8 + wave;
                    const int g = wu / 1024, rem = wu % 1024, b = rem / 256, h = (rem % 256) / 64, blk = rem % 64;
                    const int dil = (g == 0) ? 1 : (g == 1) ? 4 : 16, L = SEQ / dil, nqb = L / 32, res = blk / nqb, qb = blk % nqb;
                    const size_t row0 = (size_t)b * SEQ + res;
                    att::banded_wave_unit(PROJ + row0 * NINP + BQ_OFF + (g * 4 + h) * 128, (long)dil * NINP, PROJ + row0 * NINP + BK_OFF + h * 128, (long)dil * NINP,
                                          PROJ + row0 * NINP + BV_OFF + h * 128, (long)dil * NINP, qb * 32, L,
                                          OB + ((size_t)g * T + row0) * 512 + h * 128, (long)dil * 512, LSE + ((size_t)g * T + row0) * 4 + h, (long)dil * 4, (char*)lds + wave * 8448);
                } }
            }
        } else if (k == 4 && PH_EN(4)) {
            for (int m = gw; m < T; m += NGW) outnorm_row(Y + (size_t)m * DM, OB, LSE, m, AP(9) + l * DM, YN + (size_t)m * DM, lane);
        } else if (k == 5 && PH_EN(5)) {
            pg8::Gemm g{YN, (const pg8::bf16_t*)(wl + WL_OUT), T, DM, DM, DM}; pg8::StaticOrder S; S.init(T, DM, G, bx);
            if (l == 0) { pg8::EpiRes<true> E{AP(0), X, DM}; pg8::gemm_phase<pg8::EpiRes<true>, pg8::StaticOrder, true, true>((LAS unsigned char*)lds, g, S, E); }
            else { pg8::EpiRes<false> E{X2, X, DM}; pg8::gemm_phase<pg8::EpiRes<false>, pg8::StaticOrder, true, true>((LAS unsigned char*)lds, g, S, E); }
        } else if (k == 6 && PH_EN(6)) {
            for (int m = gw; m < T; m += NGW) rmsb_row(X + (size_t)m * DM, AP(11) + l * DM, XN + (size_t)m * DM, nullptr, lane);
        } else if (k == 7 && PH_EN(7)) {
            pg8::Gemm g{XN, (const pg8::bf16_t*)(wl + WL_UP), T, NUP, DM, DM}; pg8::StaticOrder S; S.init(T, NUP, G, bx);
            pg8::EpiConvAct E{ACT, (float*)(ws + WS_HB), AP(13) + (size_t)l * 3 * NUP, AP(14) + (size_t)l * NUP, DFF, NUP};
            pg8::gemm_phase<pg8::EpiConvAct, pg8::StaticOrder, true, true>((LAS unsigned char*)lds, g, S, E);
        } else if (k == 8 && PH_EN(8)) {
            { const float* HBp = (const float*)(ws + WS_HB); const float* cw = AP(13) + (size_t)l * 3 * NUP; const float* cb = AP(14) + (size_t)l * NUP;
              for (int it = bx * NTHR + tid; it < (T / 256) * 2 * (DFF / 8); it += G * NTHR) { const int pm = it / (2 * (DFF / 8)), r2 = it % (2 * (DFF / 8)), bot = r2 / (DFF / 8), c = (r2 % (DFF / 8)) * 8;
                      if ((bot == 0 && (pm % 8) == 0) || (bot == 1 && (pm % 8) == 7)) continue;
                      const int pc = 256 * (c / 128) + (c % 128);
                      const float* rp = bot ? HBp + ((size_t)pm * 4 + 2) * NUP : HBp + ((size_t)(pm - 1) * 4 + 3) * NUP;
                      const float* rc = bot ? HBp + ((size_t)pm * 4 + 3) * NUP : HBp + ((size_t)pm * 4 + 0) * NUP;
                      const float* rn = bot ? HBp + ((size_t)(pm + 1) * 4 + 0) * NUP : HBp + ((size_t)pm * 4 + 1) * NUP;
                      float o[8];
#pragma unroll
                      for (int hq = 0; hq < 2; ++hq) {
                          const f32x4 pg = *(const f32x4*)(rp + pc + 4 * hq), cg = *(const f32x4*)(rc + pc + 4 * hq), ng = *(const f32x4*)(rn + pc + 4 * hq);
                          const f32x4 pu = *(const f32x4*)(rp + pc + 128 + 4 * hq), cu = *(const f32x4*)(rc + pc + 128 + 4 * hq), nu = *(const f32x4*)(rn + pc + 128 + 4 * hq);
                          const f32x4 g0 = *(const f32x4*)(cw + c + 4 * hq), g1 = *(const f32x4*)(cw + NUP + c + 4 * hq), g2 = *(const f32x4*)(cw + 2 * NUP + c + 4 * hq), gb = *(const f32x4*)(cb + c + 4 * hq);
                          const f32x4 u0 = *(const f32x4*)(cw + DFF + c + 4 * hq), u1 = *(const f32x4*)(cw + NUP + DFF + c + 4 * hq), u2 = *(const f32x4*)(cw + 2 * NUP + DFF + c + 4 * hq), ub = *(const f32x4*)(cb + DFF + c + 4 * hq);
#pragma unroll
                          for (int j = 0; j < 4; ++j) { const float gg = gb[j] + g0[j] * pg[j] + g1[j] * cg[j] + g2[j] * ng[j], uv = ub[j] + u0[j] * pu[j] + u1[j] * cu[j] + u2[j] * nu[j];
                              o[4 * hq + j] = gg * __builtin_amdgcn_rcpf(1.f + __builtin_amdgcn_exp2f(-1.4426950408889634f * gg)) * uv; } }
                      v4u w; w.x = pk2(o[0], o[1]); w.y = pk2(o[2], o[3]); w.z = pk2(o[4], o[5]); w.w = pk2(o[6], o[7]);
                      *(v4u*)(ACT + (size_t)(pm * 256 + (bot ? 255 : 0)) * DFF + c) = w; } }
        } else if (k == 9 && PH_EN(9)) {
            pg8::Gemm g{ACT, (const pg8::bf16_t*)(wl + WL_DN), T, DM, DFF, DFF}; pg8::StaticOrder S; S.init(T, DM, G, bx);
            pg8::EpiRes<false> E{X, X2, DM}; pg8::gemm_phase<pg8::EpiRes<false>, pg8::StaticOrder, true, true>((LAS unsigned char*)lds, g, S, E);
        } else {
            if (l + 1 < DEPTH) { for (int m = gw; m < T; m += NGW) rmsb_row(X2 + (size_t)m * DM, AP(1) + (l + 1) * DM, XN + (size_t)m * DM, nullptr, lane); }
            else { for (int m = gw; m < T; m += NGW) rmsb_row(X2 + (size_t)m * DM, AP(16), nullptr, ((float*)AP(17)) + (size_t)m * DM, lane); }
        }
#ifdef EXTRA_SYNCS
        if (ph == 0) for (int e_ = 0; e_ < EXTRA_SYNCS; ++e_) GRID_BAR();
#endif
#ifdef REP_PH
        if (it_ + 1 < a.ph_hi + REP_X) GRID_BAR();
#else
        if (ph + 1 < a.ph_hi) GRID_BAR();
#endif
#ifdef DIAG_A
        if (bx == 0 && threadIdx.x == 0) ((unsigned long long*)ws)[16 + ph + 1] = __builtin_amdgcn_s_memrealtime();
#endif
    }
#ifdef DIAG_A
    grid.sync();
    if (bx == 0) { const unsigned long long* ts = (const unsigned long long*)ws + 16;
        const float dA = (float)(ts[DIAG_A1] - ts[DIAG_A]) * 0.01f, dB = (float)(ts[DIAG_B1] - ts[DIAG_B]) * 0.01f;
        if (threadIdx.x == 0) ((float*)AP(17))[0] += dA;
        for (int i = threadIdx.x; i < 10000; i += NTHR) ((float*)AP(17))[2048 + i] += 0.1f * dB; }
#endif
}
#undef AP
#undef XN
#undef X
#undef X2
#undef PROJ
#undef QC
#undef KC
#undef VC
#undef OB
#undef LSE
#undef H
#undef Y
#undef YN
#undef ACT

#ifndef N_LAUNCH_MODE
#define N_LAUNCH_MODE 1
#endif
extern "C" void kernel_launch(void* const* d_in, const int* in_sizes, int n_in, void* d_out, int out_size, void* d_ws, size_t ws_size, hipStream_t stream) {
    static int grid = 0;
    if (grid == 0) {
        if (n_in != 17 || out_size != T * DM || ws_size < WS_END) { fprintf(stderr, "kernel_launch: unexpected shapes: n_in %d out %d ws %zu (need %zu)\n", n_in, out_size, ws_size, (size_t)WS_END); grid = -1; return; }
        int dev = 0, cus = 0, per_cu = 0;
        if (hipGetDevice(&dev) != hipSuccess || hipDeviceGetAttribute(&cus, hipDeviceAttributeMultiprocessorCount, dev) != hipSuccess) { grid = -1; return; }
        if (hipFuncSetAttribute((const void*)fwd, hipFuncAttributeMaxDynamicSharedMemorySize, LDS_BYTES) != hipSuccess) { fprintf(stderr, "kernel_launch: hipFuncSetAttribute failed\n"); grid = -1; return; }
        if (hipOccupancyMaxActiveBlocksPerMultiprocessor(&per_cu, (const void*)fwd, NTHR, LDS_BYTES) != hipSuccess || per_cu < 1) { fprintf(stderr, "kernel_launch: occupancy query says %d\n", per_cu); (void)hipGetLastError(); }
        grid = cus;
        fprintf(stderr, "kernel_launch: grid %d per_cu %d ws %zu need %zu\n", grid, per_cu, ws_size, (size_t)WS_END);
    }
    if (grid < 0) return;
    if (hipMemsetAsync(d_ws, 0, CTL_ZERO_BYTES, stream) != hipSuccess) { fprintf(stderr, "kernel_launch: memset failed\n"); return; }
    Args a{};
    a.x = (const float*)d_in[0]; a.attn_norm = (const float*)d_in[1]; a.w_in = (const float*)d_in[2]; a.a_q_norm = (const float*)d_in[3]; a.a_k_norm = (const float*)d_in[4];
    a.c_q_norm = (const float*)d_in[5]; a.c_kv_norm = (const float*)d_in[6]; a.w_uq = (const float*)d_in[7]; a.w_ukv = (const float*)d_in[8]; a.out_norm = (const float*)d_in[9];
    a.w_out = (const float*)d_in[10]; a.ffn_norm = (const float*)d_in[11]; a.w_up = (const float*)d_in[12]; a.conv_w = (const float*)d_in[13]; a.conv_b = (const float*)d_in[14];
    a.w_down = (const float*)d_in[15]; a.final_norm = (const float*)d_in[16];
    a.out = (float*)d_out; a.ws = (unsigned char*)d_ws;
#if N_LAUNCH_MODE == 1
    a.ph_lo = 0; a.ph_hi = NPH;
    { void* args[] = {&a}; hipError_t e = hipLaunchCooperativeKernel((void*)fwd, dim3(grid), dim3(NTHR), args, LDS_BYTES, stream);
      if (e != hipSuccess) fprintf(stderr, "kernel_launch: cooperative launch failed: %s\n", hipGetErrorString(e)); }
#else
    for (int ph = 0; ph < NPH; ++ph) { a.ph_lo = ph; a.ph_hi = ph + 1; void* args[] = {&a};
        hipError_t e = hipLaunchCooperativeKernel((void*)fwd, dim3(grid), dim3(NTHR), args, LDS_BYTES, stream);
        if (e != hipSuccess) { fprintf(stderr, "kernel_launch: launch %d failed: %s\n", ph, hipGetErrorString(e)); break; } }
#endif
}
```

```cpp
#include <hip/hip_runtime.h>
#include <hip/hip_cooperative_groups.h>
#include <hip/hip_bf16.h>
#include <cstdio>
#include <cstdint>
#include <cmath>
namespace cg = cooperative_groups;
namespace pg8 {
#define PG8_LAS __attribute__((address_space(3)))
typedef unsigned short bf16_t;
typedef short bf16x8 __attribute__((ext_vector_type(8)));
typedef float f32x4 __attribute__((ext_vector_type(4)));
typedef unsigned u32x4 __attribute__((ext_vector_type(4)));
constexpr int BM = 256, BK = 64, HALF = 128, HTB = HALF * BK * 2  , STAGE_BYTES = 8 * HTB, NXCD = 8, WGM = 8;

__host__ __device__ __forceinline__ int lds_byte(int r, int c) { const int st = (r >> 4) * 2 + (c >> 5), rr = r & 15, cc = c & 31, ob = rr * 64 + cc * 2; return st * 1024 + (ob ^ (((ob >> 9) & 1) << 5)); }
__host__ __device__ __forceinline__ void stage_rc(int b, int& R, int& C) { const int st = b / 1024, sb = b % 1024, swz = sb ^ (((sb >> 9) & 1) << 5); R = (st >> 1) * 16 + swz / 64; C = (st & 1) * 32 + (swz % 64) / 2; }
__host__ __device__ __forceinline__ int perm32(int rho) { const int n = rho >> 4, i = rho & 15; return 8 * (i >> 2) + 4 * n + (i & 3); }

struct Unit { int pm, pn; };
struct Gemm { const bf16_t* A; const bf16_t* Bt; int M, N, K, lda; };

struct StaticOrder {
    int nM, nN, nwg, G, c;
    __host__ __device__ void init(int M, int N, int G_, int c_) { nM = M / BM; nN = N / BM; nwg = nM * nN; G = G_; c = c_; }
    __host__ __device__ bool next(int i, Unit& u) const {
        const long L = (long)i * G + c; if (L >= nwg) return false;
        int wgid = (int)L; { const int q = nwg / NXCD, r = nwg % NXCD, xcd = wgid % NXCD, off = wgid / NXCD; wgid = (xcd < r ? xcd * (q + 1) : r * (q + 1) + (xcd - r) * q) + off; }
        const int nig = WGM * nN, gid = wgid / nig, fm = gid * WGM, gsz = (nM - fm) < WGM ? (nM - fm) : WGM;
        u.pm = fm + ((wgid % nig) % gsz); u.pn = (wgid % nig) / gsz; return true;
    }
    __device__ __forceinline__ void a_ready(const Unit&) const {}
    __device__ __forceinline__ void done(const Unit&) const {}
};

__device__ __forceinline__ unsigned cvt_pk_bf16(float lo, float hi) { unsigned r; asm volatile("v_cvt_pk_bf16_f32 %0, %1, %2" : "=v"(r) : "v"(lo), "v"(hi)); return r; }

template <int MODE> struct EpiBf16G {
    static constexpr bool PERM = true, AFTER_DRAIN = false, USES_LDS = false;
    bf16_t* O; int ldc; int ncols; bf16_t* O2; int ldc2;
    __device__ __forceinline__ void operator()(const f32x4 (&acc)[2][2][4][2], const Unit& u, int wr, int wc, int fr, int fq) const {
        const int row0 = u.pm * BM + wr * 64 + fr;
#pragma unroll
        for (int ai = 0; ai < 2; ++ai)
#pragma unroll
            for (int m = 0; m < 4; ++m) { const size_t row = (size_t)(row0 + ai * HALF + m * 16);
#pragma unroll
                for (int bj = 0; bj < 2; ++bj) {
                    const f32x4 v0 = acc[ai][bj][m][0], v1 = acc[ai][bj][m][1];
                    u32x4 w; w.x = cvt_pk_bf16(v0[0], v0[1]); w.y = cvt_pk_bf16(v0[2], v0[3]); w.z = cvt_pk_bf16(v1[0], v1[1]); w.w = cvt_pk_bf16(v1[2], v1[3]);
                    if (MODE == 0) { const int col = u.pn * BM + bj * HALF + wc * 32 + 8 * fq; if (col < ncols) *(u32x4*)(O + row * ldc + col) = w; }
                    else { if (bj == 0) *(u32x4*)(O + row * ldc + u.pn * 192 + wc * 32 + 8 * fq) = w; else *(u32x4*)(O2 + row * ldc2 + u.pn * 128 + wc * 32 + 8 * fq) = w; }
                } }
    }
};
template <bool BASE_F32> struct EpiRes {
    static constexpr bool PERM = false, AFTER_DRAIN = false, USES_LDS = false;
    const void* base; bf16_t* out; int ldc;
    __device__ __forceinline__ void operator()(const f32x4 (&acc)[2][2][4][2], const Unit& u, int wr, int wc, int fr, int fq) const {
        typedef unsigned u32x2v __attribute__((ext_vector_type(2)));
        const int row0 = u.pm * BM + wr * 64 + fr, col0 = u.pn * BM + wc * 32 + 4 * fq;
#pragma unroll
        for (int ai = 0; ai < 2; ++ai)
#pragma unroll
            for (int m = 0; m < 4; ++m) { const size_t off = (size_t)(row0 + ai * HALF + m * 16) * ldc + col0;
#pragma unroll
                for (int bj = 0; bj < 2; ++bj)
#pragma unroll
                    for (int n = 0; n < 2; ++n) { f32x4 b;
                        if (BASE_F32) b = *(const f32x4*)((const float*)base + off + bj * HALF + n * 16);
                        else { const u32x2v r = *(const u32x2v*)((const bf16_t*)base + off + bj * HALF + n * 16);
                               b = (f32x4){__builtin_bit_cast(float, r.x << 16), __builtin_bit_cast(float, r.x & 0xffff0000u), __builtin_bit_cast(float, r.y << 16), __builtin_bit_cast(float, r.y & 0xffff0000u)}; }
                        const f32x4 v = b + acc[ai][bj][m][n]; u32x2v w; w.x = cvt_pk_bf16(v[0], v[1]); w.y = cvt_pk_bf16(v[2], v[3]);
                        *(u32x2v*)(out + off + bj * HALF + n * 16) = w; } }
    }
};
__device__ __forceinline__ float dpp_prev(float x, float xm) {
    const int e = __builtin_amdgcn_mov_dpp(__builtin_bit_cast(int, xm), 0x121, 0xf, 0xf, false);
    return __builtin_bit_cast(float, __builtin_amdgcn_update_dpp(e, __builtin_bit_cast(int, x), 0x111, 0xf, 0xf, false)); }
__device__ __forceinline__ float dpp_next(float x, float xp) {
    const int e = __builtin_amdgcn_mov_dpp(__builtin_bit_cast(int, xp), 0x12f, 0xf, 0xf, false);
    return __builtin_bit_cast(float, __builtin_amdgcn_update_dpp(e, __builtin_bit_cast(int, x), 0x101, 0xf, 0xf, false)); }
struct EpiConvAct {
    static constexpr bool PERM = true, AFTER_DRAIN = false, USES_LDS = true;
    bf16_t* ACT; float* HB; const float* cw; const float* cb; int dff, nup;
    __device__ __forceinline__ void run(const f32x4 (&acc)[2][2][4][2], const Unit& u, int wr, int wc, int fr_, int fq_, PG8_LAS unsigned char* xl, int wid, int lane) const {
        int fr = fr_, fq = fq_; asm volatile("" : "+v"(fr), "+v"(fq));
        PG8_LAS float* X = (PG8_LAS float*)xl;
#pragma unroll
        for (int ai = 0; ai < 2; ++ai)
#pragma unroll
            for (int bj = 0; bj < 2; ++bj)
#pragma unroll
                for (int n = 0; n < 2; ++n) {
                    if (fr == 0)  *(PG8_LAS f32x4*)(X + ((((wid * 2 + ai) * 2 + 0) * 2 + bj) * 2 + n) * 16 + fq * 4) = acc[ai][bj][0][n];
                    if (fr == 15) *(PG8_LAS f32x4*)(X + ((((wid * 2 + ai) * 2 + 1) * 2 + bj) * 2 + n) * 16 + fq * 4) = acc[ai][bj][3][n];
                }
        if (wr == 0 && fr < 2) { float* hb = HB + ((size_t)u.pm * 4 + fr) * nup + u.pn * BM + wc * 32 + 8 * fq;
#pragma unroll
            for (int bj = 0; bj < 2; ++bj)
#pragma unroll
                for (int n = 0; n < 2; ++n) *(f32x4*)(hb + bj * HALF + 4 * n) = acc[0][bj][0][n]; }
        if (wr == 1 && fr >= 14) { float* hb = HB + ((size_t)u.pm * 4 + 2 + (fr - 14)) * nup + u.pn * BM + wc * 32 + 8 * fq;
#pragma unroll
            for (int bj = 0; bj < 2; ++bj)
#pragma unroll
                for (int n = 0; n < 2; ++n) *(f32x4*)(hb + bj * HALF + 4 * n) = acc[1][bj][3][n]; }
        asm volatile("s_waitcnt lgkmcnt(0)" ::: "memory"); __builtin_amdgcn_s_barrier(); asm volatile("" ::: "memory");
        const int ch0 = u.pn * HALF + wc * 32 + 8 * fq;
        const int pw = wid ^ 4;
#pragma unroll
        for (int ai = 0; ai < 2; ++ai) {
            unsigned pk[4][2][2];
#pragma unroll
            for (int n = 0; n < 2; ++n) {
                f32x4 wg[3], wu[3];
#pragma unroll
                for (int k = 0; k < 3; ++k) { wg[k] = *(const f32x4*)(cw + (size_t)k * nup + ch0 + 4 * n); wu[k] = *(const f32x4*)(cw + (size_t)k * nup + dff + ch0 + 4 * n); }
                const f32x4 bg = *(const f32x4*)(cb + ch0 + 4 * n), bu = *(const f32x4*)(cb + dff + ch0 + 4 * n);
#pragma unroll
                for (int m = 0; m < 4; ++m) {
                    f32x4 cv[2];
#pragma unroll
                    for (int bj = 0; bj < 2; ++bj) {
                        const f32x4 x = acc[ai][bj][m][n];
                        f32x4 xm, xp; const f32x4 z = (f32x4){0.f, 0.f, 0.f, 0.f};
                        if (m > 0) xm = acc[ai][bj][m > 0 ? m - 1 : 0][n];
                        else if (wr == 1) xm = *(PG8_LAS f32x4*)(X + ((((pw * 2 + ai) * 2 + 1) * 2 + bj) * 2 + n) * 16 + fq * 4);
                        else if (ai == 1) xm = *(PG8_LAS f32x4*)(X + ((((pw * 2 + 0) * 2 + 1) * 2 + bj) * 2 + n) * 16 + fq * 4);
                        else xm = z;
                        if (m < 3) xp = acc[ai][bj][m < 3 ? m + 1 : 3][n];
                        else if (wr == 0) xp = *(PG8_LAS f32x4*)(X + ((((pw * 2 + ai) * 2 + 0) * 2 + bj) * 2 + n) * 16 + fq * 4);
                        else if (ai == 0) xp = *(PG8_LAS f32x4*)(X + ((((pw * 2 + 1) * 2 + 0) * 2 + bj) * 2 + n) * 16 + fq * 4);
                        else xp = z;
                        const f32x4 w0 = bj ? wu[0] : wg[0], w1 = bj ? wu[1] : wg[1], w2 = bj ? wu[2] : wg[2], bb = bj ? bu : bg;
                        f32x4 pv, nx;
#pragma unroll
                        for (int j = 0; j < 4; ++j) { pv[j] = dpp_prev(x[j], xm[j]); nx[j] = dpp_next(x[j], xp[j]); }
                        cv[bj] = bb + w0 * pv + w1 * x + w2 * nx;
                    }
                    f32x4 o; { const f32x4 g = cv[0], t = g * (-1.4426950408889634f); f32x4 d;
#pragma unroll
                      for (int j = 0; j < 4; ++j) d[j] = __builtin_amdgcn_exp2f(t[j]);
                      d = d + 1.f;
#pragma unroll
                      for (int j = 0; j < 4; ++j) d[j] = __builtin_amdgcn_rcpf(d[j]);
                      o = (g * d) * cv[1]; }
                    pk[m][n][0] = cvt_pk_bf16(o[0], o[1]); pk[m][n][1] = cvt_pk_bf16(o[2], o[3]);
                }
            }
#pragma unroll
            for (int m = 0; m < 4; ++m) { u32x4 w; w.x = pk[m][0][0]; w.y = pk[m][0][1]; w.z = pk[m][1][0]; w.w = pk[m][1][1];
                *(u32x4*)(ACT + (size_t)(u.pm * BM + ai * HALF + wr * 64 + m * 16 + fr) * dff + ch0) = w; }
            asm volatile("" ::: "memory");
        }
    }
};
template <class Epi, class Sched, bool ALIGN_EPI = false, bool SP2 = false>
__device__ __forceinline__ void gemm_phase(PG8_LAS unsigned char* lds, const Gemm g, const Sched& S, const Epi& E) {
    int tid_ = threadIdx.x; asm volatile("" : "+v"(tid_));
    const int tid = tid_, wid = __builtin_amdgcn_readfirstlane(tid >> 6), lane = tid & 63, wr = wid >> 2, wc = wid & 3, fr = lane & 15, fq = lane >> 4;
    const int K = g.K, nt = K / BK;
    unsigned voffA[2], voffB[2];
#pragma unroll
    for (int i = 0; i < 2; ++i) { int R, C; stage_rc(tid * 16 + i * 8192, R, C); const int Rb = Epi::PERM ? ((R & ~31) + perm32(R & 31)) : R;
        voffA[i] = (unsigned)(R * g.lda + C) * 2u; voffB[i] = (unsigned)(Rb * K + C) * 2u; }
    const size_t kstep = (size_t)(BK * 2);
    const size_t hstepA = (size_t)HALF * g.lda * 2, hstepB = (size_t)HALF * K * 2;
    const size_t tstepA = 2 * hstepA, tstepB = 2 * hstepB;
    const unsigned ldsw = (unsigned)wid * 1024u;
    const int aoff = lds_byte(wr * 64 + fr, fq * 8), boff = lds_byte(wc * 32 + fr, fq * 8);
#define PG8_SA(b, h) (((b) * 2 + (h)) * HTB)
#define PG8_SB(b, h) ((4 + (b) * 2 + (h)) * HTB)
#define PG8_STAGE(bufoff, gbase, voff) do { _Pragma("unroll") for (int _i = 0; _i < 2; ++_i) \
        __builtin_amdgcn_global_load_lds((const unsigned*)((const char*)(gbase) + (voff)[_i]), (PG8_LAS unsigned*)(lds + (bufoff) + ldsw + _i * 8192), 16, 0, 0); } while (0)
#define PG8_LDA(dst, b, h) do { _Pragma("unroll") for (int m = 0; m < 4; ++m) _Pragma("unroll") for (int k = 0; k < 2; ++k) dst[m][k] = *(const PG8_LAS bf16x8*)(lds + PG8_SA(b, h) + aoff + m * 2048 + k * 1024); } while (0)
#define PG8_LDB(dst, b, h) do { _Pragma("unroll") for (int n = 0; n < 2; ++n) _Pragma("unroll") for (int k = 0; k < 2; ++k) dst[n][k] = *(const PG8_LAS bf16x8*)(lds + PG8_SB(b, h) + boff + n * 2048 + k * 1024); } while (0)
#define PG8_MMA(ai, bj, At, Bt) do { __builtin_amdgcn_s_setprio(1); _Pragma("unroll") for (int m = 0; m < 4; ++m) _Pragma("unroll") for (int n = 0; n < 2; ++n) _Pragma("unroll") for (int k = 0; k < 2; ++k) \
        acc[ai][bj][m][n] = __builtin_amdgcn_mfma_f32_16x16x32_bf16(Bt[n][k], At[m][k], acc[ai][bj][m][n], 0, 0, 0); __builtin_amdgcn_s_setprio(0); } while (0)
#define PG8_WAIT_V(n) asm volatile("s_waitcnt vmcnt(" #n ")" ::: "memory")
#define PG8_WAIT_L(n) asm volatile("s_waitcnt lgkmcnt(" #n ")" ::: "memory")
#define PG8_BAR __builtin_amdgcn_s_barrier()
#define PG8_SCHED __builtin_amdgcn_sched_barrier(0)
    Unit cur, nxt; int ui = 0;
    if (!S.next(0, cur)) return;
    f32x4 acc[2][2][4][2];
#pragma unroll
    for (int a = 0; a < 2; ++a)
#pragma unroll
        for (int b = 0; b < 2; ++b)
#pragma unroll
            for (int m = 0; m < 4; ++m)
#pragma unroll
                for (int n = 0; n < 2; ++n) acc[a][b][m][n] = (f32x4){0.f, 0.f, 0.f, 0.f};
    bf16x8 At[4][2], B0[2][2], B1[2][2];
    const char* cA = (const char*)g.A + (size_t)cur.pm * tstepA; const char* cB = (const char*)g.Bt + (size_t)cur.pn * tstepB;
    S.a_ready(cur);
    if constexpr (SP2) {
        PG8_STAGE(PG8_SB(0, 0), cB, voffB); PG8_STAGE(PG8_SB(0, 1), cB + hstepB, voffB); PG8_STAGE(PG8_SA(0, 0), cA, voffA); PG8_STAGE(PG8_SA(0, 1), cA + hstepA, voffA);
        if (wr == 1) PG8_BAR;
        PG8_WAIT_V(2); PG8_BAR;
        PG8_STAGE(PG8_SB(1, 0), cB + kstep, voffB); PG8_STAGE(PG8_SA(1, 0), cA + kstep, voffA); PG8_STAGE(PG8_SB(1, 1), cB + hstepB + kstep, voffB);
        PG8_WAIT_V(6); PG8_BAR;
    } else {
        PG8_STAGE(PG8_SB(0, 0), cB, voffB); PG8_STAGE(PG8_SA(0, 0), cA, voffA); PG8_STAGE(PG8_SB(0, 1), cB + hstepB, voffB); PG8_STAGE(PG8_SA(0, 1), cA + hstepA, voffA);
        if (wr == 1) PG8_BAR;
        PG8_WAIT_V(4); PG8_BAR;
        PG8_STAGE(PG8_SB(1, 0), cB + kstep, voffB); PG8_STAGE(PG8_SA(1, 0), cA + kstep, voffA); PG8_STAGE(PG8_SB(1, 1), cB + hstepB + kstep, voffB);
        PG8_WAIT_V(6); PG8_BAR;
    }
    for (;;) {
        const bool has_next = S.next(ui + 1, nxt);
        const char* nA = has_next ? (const char*)g.A + (size_t)nxt.pm * tstepA : cA; const char* nB = has_next ? (const char*)g.Bt + (size_t)nxt.pn * tstepB : cB;
        for (int t = 0; t < nt; t += 2) {
            const bool last = (t == nt - 2);
            const char* a1 = cA + (size_t)(t + 1) * kstep;
            const char* a2 = last ? nA : cA + (size_t)(t + 2) * kstep; const char* b2 = last ? nB : cB + (size_t)(t + 2) * kstep;
            const char* a3 = a2 + kstep; const char* b3 = b2 + kstep;
            if (last && has_next) S.a_ready(nxt);
            if constexpr (SP2) {
            PG8_LDB(B0, 0, 0); PG8_LDB(B1, 0, 1); PG8_SCHED; PG8_LDA(At, 0, 0); PG8_STAGE(PG8_SA(1, 1), a1 + hstepA, voffA);
            PG8_WAIT_V(8); PG8_WAIT_L(0); PG8_BAR; PG8_MMA(0, 0, At, B0); PG8_MMA(0, 1, At, B1); PG8_BAR; PG8_SCHED;
            PG8_LDA(At, 0, 1); PG8_STAGE(PG8_SB(0, 0), b2, voffB); PG8_STAGE(PG8_SB(0, 1), b2 + hstepB, voffB); PG8_STAGE(PG8_SA(0, 0), a2, voffA);
            PG8_WAIT_V(8); PG8_WAIT_L(0); PG8_BAR; PG8_MMA(1, 0, At, B0); PG8_MMA(1, 1, At, B1); PG8_BAR; PG8_SCHED;
            PG8_LDB(B0, 1, 0); PG8_LDB(B1, 1, 1); PG8_SCHED; PG8_LDA(At, 1, 0); PG8_STAGE(PG8_SA(0, 1), a2 + hstepA, voffA);
            PG8_WAIT_V(8); PG8_WAIT_L(0); PG8_BAR; PG8_MMA(0, 0, At, B0); PG8_MMA(0, 1, At, B1); PG8_BAR; PG8_SCHED;
            PG8_LDA(At, 1, 1); PG8_STAGE(PG8_SB(1, 0), b3, voffB); PG8_STAGE(PG8_SB(1, 1), b3 + hstepB, voffB); PG8_STAGE(PG8_SA(1, 0), a3, voffA);
            PG8_WAIT_V(8); PG8_WAIT_L(0); PG8_BAR; PG8_MMA(1, 0, At, B0); PG8_MMA(1, 1, At, B1); PG8_BAR; PG8_SCHED;
            } else {
            PG8_LDB(B0, 0, 0); PG8_SCHED; PG8_LDA(At, 0, 0); PG8_STAGE(PG8_SA(1, 1), a1 + hstepA, voffA);
            PG8_WAIT_L(8); PG8_BAR; PG8_WAIT_L(0); PG8_MMA(0, 0, At, B0); PG8_BAR; PG8_SCHED;
            PG8_LDB(B1, 0, 1); PG8_STAGE(PG8_SB(0, 0), b2, voffB);
            PG8_BAR; PG8_WAIT_L(0); PG8_MMA(0, 1, At, B1); PG8_BAR;
            PG8_LDA(At, 0, 1); PG8_STAGE(PG8_SA(0, 0), a2, voffA);
            PG8_BAR; PG8_WAIT_L(0); PG8_MMA(1, 0, At, B0); PG8_BAR; PG8_SCHED;
            PG8_STAGE(PG8_SB(0, 1), b2 + hstepB, voffB);
            PG8_WAIT_V(6); PG8_BAR; PG8_MMA(1, 1, At, B1); PG8_BAR;
            PG8_LDB(B0, 1, 0); PG8_SCHED; PG8_LDA(At, 1, 0); PG8_STAGE(PG8_SA(0, 1), a2 + hstepA, voffA);
            PG8_WAIT_L(8); PG8_BAR; PG8_WAIT_L(0); PG8_MMA(0, 0, At, B0); PG8_BAR; PG8_SCHED;
            PG8_LDB(B1, 1, 1); PG8_STAGE(PG8_SB(1, 0), b3, voffB);
            PG8_BAR; PG8_WAIT_L(0); PG8_MMA(0, 1, At, B1); PG8_BAR;
            PG8_LDA(At, 1, 1); PG8_STAGE(PG8_SA(1, 0), a3, voffA);
            PG8_BAR; PG8_WAIT_L(0); PG8_MMA(1, 0, At, B0); PG8_BAR; PG8_SCHED;
            PG8_STAGE(PG8_SB(1, 1), b3 + hstepB, voffB);
            PG8_WAIT_V(6); PG8_BAR; PG8_MMA(1, 1, At, B1); PG8_BAR;
            }
        }
        if constexpr (ALIGN_EPI) { if (wr == 0) PG8_BAR; }
        if constexpr (!Epi::AFTER_DRAIN) { if constexpr (Epi::USES_LDS) E.run(acc, cur, wr, wc, fr, fq, lds + STAGE_BYTES + 2048, wid, lane); else E(acc, cur, wr, wc, fr, fq); S.done(cur); }
        if (!has_next) break;
#pragma unroll
        for (int a = 0; a < 2; ++a)
#pragma unroll
            for (int b = 0; b < 2; ++b)
#pragma unroll
                for (int m = 0; m < 4; ++m)
#pragma unroll
                    for (int n = 0; n < 2; ++n) acc[a][b][m][n] = (f32x4){0.f, 0.f, 0.f, 0.f};
        cur = nxt; cA = nA; cB = nB; ++ui;
        if constexpr (ALIGN_EPI) { if (wr == 1) PG8_BAR; }
    }
    PG8_WAIT_V(0);
    if constexpr (!ALIGN_EPI) { if (wr == 0) PG8_BAR; }
    PG8_BAR;
    if constexpr (Epi::AFTER_DRAIN) { E.fused(acc, cur, wr, wc, fr, fq, lds, wid, lane); S.done(cur); }
#undef PG8_SA
#undef PG8_SB
#undef PG8_STAGE
#undef PG8_LDA
#undef PG8_LDB
#undef PG8_MMA
#undef PG8_WAIT_V
#undef PG8_WAIT_L
#undef PG8_BAR
#undef PG8_SCHED
}
}
namespace att {
using bf16 = unsigned short;
using bf16x8 = __attribute__((ext_vector_type(8))) short;
using s16x4  = __attribute__((ext_vector_type(4))) short;
using f32x16 = __attribute__((ext_vector_type(16))) float;
using u32x4  = __attribute__((ext_vector_type(4))) unsigned;
constexpr int NW = 8, QBLK = 32, KVBLK = 64, DV = 128;
constexpr float THR = 8.f;
#define SBAR() __builtin_amdgcn_sched_barrier(0)
__device__ __forceinline__ int crow(int r, int hi) { return (r & 3) + 8 * (r >> 2) + 4 * hi; }
__device__ __forceinline__ unsigned cvtpk(float lo, float hi) { unsigned r; asm volatile("v_cvt_pk_bf16_f32 %0, %1, %2" : "=v"(r) : "v"(lo), "v"(hi)); return r; }
__device__ __forceinline__ bf16x8 ld8(const bf16* p) { return *reinterpret_cast<const bf16x8*>(p); }

__device__ __forceinline__ void partialSM(f32x16& p0, f32x16& p1, float& m_reg, float& mn, float& alpha, const float C, const float THRS) {
  float pmax = p0[0];
#pragma unroll
  for (int r = 1; r < 16; ++r) pmax = fmaxf(pmax, p0[r]);
#pragma unroll
  for (int r = 0; r < 16; ++r) pmax = fmaxf(pmax, p1[r]);
  { auto rr = __builtin_amdgcn_permlane32_swap(__float_as_uint(pmax), __float_as_uint(pmax), false, false);
    pmax = fmaxf(__uint_as_float(rr[0]), __uint_as_float(rr[1])); }
  if (__builtin_expect(__all(pmax - m_reg <= THRS), 1)) { mn = m_reg; alpha = 1.f; }
  else { mn = fmaxf(m_reg, pmax); alpha = __builtin_amdgcn_exp2f((m_reg - mn) * C); m_reg = mn; }
  float mnC = -mn * C;
#pragma unroll
  for (int r = 0; r < 16; ++r) p0[r] = fmaf(p0[r], C, mnC);
#pragma unroll
  for (int r = 0; r < 16; ++r) p1[r] = fmaf(p1[r], C, mnC);
#pragma unroll
  for (int r = 0; r < 16; ++r) p0[r] = __builtin_amdgcn_exp2f(p0[r]);
}
#define PK4(P, BASE, OUT) do { unsigned a0 = cvtpk(P[BASE + 0], P[BASE + 1]), a1 = cvtpk(P[BASE + 2], P[BASE + 3]);   \
    unsigned b0 = cvtpk(P[BASE + 4], P[BASE + 5]), b1 = cvtpk(P[BASE + 6], P[BASE + 7]);                              \
    auto r0 = __builtin_amdgcn_permlane32_swap(a0, b0, false, false); auto r1 = __builtin_amdgcn_permlane32_swap(a1, b1, false, false); \
    u32x4 w = {r0[0], r1[0], r0[1], r1[1]}; OUT = *reinterpret_cast<bf16x8*>(&w); } while (0)
__device__ __forceinline__ void finishSM(f32x16& p0, f32x16& p1, float alpha, float& l_reg, bf16x8& pa0, bf16x8& pa1, bf16x8& pa2, bf16x8& pa3) {
#pragma unroll
  for (int r = 0; r < 16; ++r) p1[r] = __builtin_amdgcn_exp2f(p1[r]);
  float ps = 0;
#pragma unroll
  for (int r = 0; r < 16; ++r) ps += p0[r];
#pragma unroll
  for (int r = 0; r < 16; ++r) ps += p1[r];
  { auto rr = __builtin_amdgcn_permlane32_swap(__float_as_uint(ps), __float_as_uint(ps), false, false);
    ps = __uint_as_float(rr[0]) + __uint_as_float(rr[1]); }
  l_reg = l_reg * alpha + ps;
  PK4(p0, 0, pa0); PK4(p0, 8, pa1); PK4(p1, 0, pa2); PK4(p1, 8, pa3);
}
template <int DK> __device__ __forceinline__ int kswz(int row, int colB) { return row * (DK * 2) + (colB ^ ((row & 7) << 4)); }
template <int DK> __device__ __forceinline__ void qkt(f32x16& p0, f32x16& p1, const char* Ks, const bf16x8* qr, int r32, int hi) {
  p0 = f32x16{}; p1 = f32x16{};
#pragma unroll
  for (int d0 = 0; d0 < DK / 16; ++d0) { int cb = (d0 * 16 + hi * 8) * 2;
    bf16x8 b0 = *reinterpret_cast<const bf16x8*>(Ks + kswz<DK>(r32, cb));
    bf16x8 b1 = *reinterpret_cast<const bf16x8*>(Ks + kswz<DK>(32 + r32, cb));
    p0 = __builtin_amdgcn_mfma_f32_32x32x16_bf16(b0, qr[d0], p0, 0, 0, 0);
    p1 = __builtin_amdgcn_mfma_f32_32x32x16_bf16(b1, qr[d0], p1, 0, 0, 0); }
}
__device__ __forceinline__ int v_st(int k, int c) { const int kk = (k & ~0xC) | ((k & 4) << 1) | ((k & 8) >> 1); return ((kk >> 3) * 4 + (c >> 5)) * 512 + ((kk & 7) * 32 + (c & 31)) * 2; }
__device__ __forceinline__ int v_rd_base(int lane) { return ((lane & 3) << 3) | (((lane >> 2) & 3) << 6) | (((lane >> 4) & 1) << 5) | (((lane >> 5) & 1) << 8); }
constexpr int v_rd_off(int d0, int ks, int half) { return d0 * 512 + ks * 4096 + half * 2048; }
template <int OFF> __device__ __forceinline__ s16x4 tr_read(int vb) {
  s16x4 r; asm volatile("ds_read_b64_tr_b16 %0, %1 offset:%2" : "=&v"(r) : "v"(vb), "i"(OFF) : "memory"); return r;
}
#define PKV(L, H) (bf16x8){L[0], L[1], L[2], L[3], H[0], H[1], H[2], H[3]}
template <int D0> __device__ __forceinline__ void pv_one(f32x16& od, int vb, bf16x8 pa0, bf16x8 pa1, bf16x8 pa2, bf16x8 pa3) {
  const s16x4 l0 = tr_read<v_rd_off(D0, 0, 0)>(vb), h0 = tr_read<v_rd_off(D0, 0, 1)>(vb), l1 = tr_read<v_rd_off(D0, 1, 0)>(vb), h1 = tr_read<v_rd_off(D0, 1, 1)>(vb);
  const s16x4 l2 = tr_read<v_rd_off(D0, 2, 0)>(vb), h2 = tr_read<v_rd_off(D0, 2, 1)>(vb), l3 = tr_read<v_rd_off(D0, 3, 0)>(vb), h3 = tr_read<v_rd_off(D0, 3, 1)>(vb);
  asm volatile("s_waitcnt lgkmcnt(0)" ::: "memory"); SBAR();
  od = __builtin_amdgcn_mfma_f32_32x32x16_bf16(pa0, PKV(l0, h0), od, 0, 0, 0);
  od = __builtin_amdgcn_mfma_f32_32x32x16_bf16(pa1, PKV(l1, h1), od, 0, 0, 0);
  od = __builtin_amdgcn_mfma_f32_32x32x16_bf16(pa2, PKV(l2, h2), od, 0, 0, 0);
  od = __builtin_amdgcn_mfma_f32_32x32x16_bf16(pa3, PKV(l3, h3), od, 0, 0, 0);
}
__device__ __forceinline__ void pv_d0(f32x16* o, int vb, bf16x8 pa0, bf16x8 pa1, bf16x8 pa2, bf16x8 pa3) {
  pv_one<0>(o[0], vb, pa0, pa1, pa2, pa3); pv_one<1>(o[1], vb, pa0, pa1, pa2, pa3); pv_one<2>(o[2], vb, pa0, pa1, pa2, pa3); pv_one<3>(o[3], vb, pa0, pa1, pa2, pa3);
}

template <int DK, int ldq, int ldk, int ldv, int ldo>
__device__ __forceinline__ void attn_dense_unit(const bf16* __restrict__ Qb, const bf16* __restrict__ Kh, const bf16* __restrict__ Vh,
                                                bf16* __restrict__ Ob, const float scale, char* lds, const int seqr, const float* __restrict__ ropetab) {
  constexpr int SHM_V = KVBLK * DV * 2, SHM_K = KVBLK * DK * 2, NQ = DK / 16, NKC = DK / 64;
  const float C = scale * 1.4426950408889634f, THRS = THR / scale;
  int tid_ = threadIdx.x; asm volatile("" : "+v"(tid_));
  const int tid = tid_, wid = tid >> 6, lane = tid & 63, r32 = lane & 31, hi = lane >> 5;
  char* V_lds = lds; char* K_lds = lds + 2 * SHM_V;
  float* ws = (float*)(lds + 2 * SHM_V + 2 * SHM_K) + wid * 64; float* li_l = ws; float* al_l = ws + 32;
  float m_reg = -1e30f, l_reg = 0; f32x16 o[4] = {}; bf16x8 qr[NQ];
  const bf16* Qw = Qb + (long)(wid * QBLK + r32) * ldq + hi * 8;
#pragma unroll
  for (int d0 = 0; d0 < NQ; ++d0) qr[d0] = ld8(Qw + d0 * 16);
  if constexpr (DK == 192) {
    const float* tp = ropetab + ((long)(wid * QBLK + r32) * 32 + hi * 8) * 2;
#pragma unroll
    for (int k = 0; k < 2; ++k) {
      u32x4 a = *reinterpret_cast<u32x4*>(&qr[8 + k]), b = *reinterpret_cast<u32x4*>(&qr[10 + k]); u32x4 oa, ob;
#pragma unroll
      for (int w = 0; w < 4; ++w) { const float4 t = *reinterpret_cast<const float4*>(tp + k * 32 + w * 4);
        const float x1l = __uint_as_float(a[w] << 16), x1h = __uint_as_float(a[w] & 0xffff0000u), x2l = __uint_as_float(b[w] << 16), x2h = __uint_as_float(b[w] & 0xffff0000u);
        oa[w] = cvtpk(x1l * t.x - x2l * t.y, x1h * t.z - x2h * t.w); ob[w] = cvtpk(x1l * t.y + x2l * t.x, x1h * t.w + x2h * t.z); }
      qr[8 + k] = *reinterpret_cast<bf16x8*>(&oa); qr[10 + k] = *reinterpret_cast<bf16x8*>(&ob); } }
  const int sr = tid >> 4, sc = (tid & 15) * 8, vst0 = v_st(sr, sc), vst1 = v_st(32 + sr, sc);
  int krow[NKC], kcol[NKC];
#pragma unroll
  for (int i = 0; i < NKC; ++i) { const int c = tid + 512 * i; krow[i] = c / (DK / 8); kcol[i] = (c % (DK / 8)) * 8; }
  const int vb0 = (int)(uintptr_t)V_lds + v_rd_base(lane);
  bf16x8 vs0, vs1, ks[NKC];
#define SLOAD(k0) do { vs0 = ld8(&Vh[(long)((k0) + sr) * ldv + sc]); vs1 = ld8(&Vh[(long)((k0) + 32 + sr) * ldv + sc]); \
    _Pragma("unroll") for (int i_ = 0; i_ < NKC; ++i_) ks[i_] = ld8(&Kh[(long)((k0) + krow[i_]) * ldk + kcol[i_]]); } while (0)
#define SWRITE(b) do { *(bf16x8*)(V_lds + (b) * SHM_V + vst0) = vs0; *(bf16x8*)(V_lds + (b) * SHM_V + vst1) = vs1; \
    _Pragma("unroll") for (int i_ = 0; i_ < NKC; ++i_) *(bf16x8*)(K_lds + (b) * SHM_K + kswz<DK>(krow[i_], kcol[i_] * 2)) = ks[i_]; } while (0)
  const int NT = seqr / KVBLK;
  SLOAD(0); SWRITE(0); __syncthreads();
  for (int j = 0; j < NT; ++j) {
    const int cb = j & 1;
    if (j + 1 < NT) SLOAD((j + 1) * KVBLK);
    SBAR();
    f32x16 p0, p1; float mn, al; bf16x8 pa0, pa1, pa2, pa3;
    qkt<DK>(p0, p1, K_lds + cb * SHM_K, qr, r32, hi);
    partialSM(p0, p1, m_reg, mn, al, C, THRS);
    if (__any(al < 1.f)) { if (hi == 0) al_l[r32] = al; asm volatile("s_waitcnt lgkmcnt(0)" ::: "memory");
#pragma unroll
      for (int d = 0; d < 4; ++d)
#pragma unroll
        for (int r = 0; r < 16; ++r) o[d][r] *= al_l[crow(r, hi)]; }
    finishSM(p0, p1, al, l_reg, pa0, pa1, pa2, pa3); SBAR();
    pv_d0(o, vb0 + cb * SHM_V, pa0, pa1, pa2, pa3);
    SBAR();
    if (j + 1 < NT) SWRITE(cb ^ 1);
    __syncthreads();
  }
  if (hi == 0) li_l[r32] = l_reg; asm volatile("s_waitcnt lgkmcnt(0)" ::: "memory");
  float rli[16];
#pragma unroll
  for (int r = 0; r < 16; ++r) rli[r] = __builtin_amdgcn_rcpf(li_l[crow(r, hi)]);
  bf16* Ow = Ob + (long)(wid * QBLK) * ldo;
#pragma unroll
  for (int r = 0; r < 16; ++r) { int orow = crow(r, hi);
#pragma unroll
    for (int d0 = 0; d0 < 4; ++d0) Ow[(long)orow * ldo + d0 * 32 + r32] = (bf16)(cvtpk(o[d0][r] * rli[r], 0.f) & 0xffffu); }
  __syncthreads();
#undef SLOAD
#undef SWRITE
}

template <int DK, int SDEPTH, int ldq, int ldk, int ldv, int ldo>
__device__ __forceinline__ void attn_dense_unit2(const bf16* __restrict__ Qb, const bf16* __restrict__ Kh, const bf16* __restrict__ Vh,
                                                bf16* __restrict__ Ob, const float scale, char* lds, const int seqr, const float* __restrict__ ropetab) {
  constexpr int SHM_V = KVBLK * DV * 2, SHM_K = KVBLK * DK * 2, NQ = DK / 16, NKC = DK / 64;
  const float C = scale * 1.4426950408889634f, THRS = THR / scale;
  int tid_ = threadIdx.x; asm volatile("" : "+v"(tid_));
  const int tid = tid_, wid = tid >> 6, lane = tid & 63, r32 = lane & 31, hi = lane >> 5;
  char* V_lds = lds; char* K_lds = lds + 2 * SHM_V;
  float* ws = (float*)(lds + 2 * SHM_V + 2 * SHM_K) + wid * 64; float* li_l = ws; float* al_l = ws + 32;
  float m_reg = -1e30f, l_reg = 0; f32x16 o[4] = {}; bf16x8 qr[NQ];
  const bf16* Qw = Qb + (long)(wid * QBLK + r32) * ldq + hi * 8;
#pragma unroll
  for (int d0 = 0; d0 < NQ; ++d0) qr[d0] = ld8(Qw + d0 * 16);
  if constexpr (DK == 192) {
    const float* tp = ropetab + ((long)(wid * QBLK + r32) * 32 + hi * 8) * 2;
#pragma unroll
    for (int k = 0; k < 2; ++k) {
      u32x4 a = *reinterpret_cast<u32x4*>(&qr[8 + k]), b = *reinterpret_cast<u32x4*>(&qr[10 + k]); u32x4 oa, ob;
#pragma unroll
      for (int w = 0; w < 4; ++w) { const float4 t = *reinterpret_cast<const float4*>(tp + k * 32 + w * 4);
        const float x1l = __uint_as_float(a[w] << 16), x1h = __uint_as_float(a[w] & 0xffff0000u), x2l = __uint_as_float(b[w] << 16), x2h = __uint_as_float(b[w] & 0xffff0000u);
        oa[w] = cvtpk(x1l * t.x - x2l * t.y, x1h * t.z - x2h * t.w); ob[w] = cvtpk(x1l * t.y + x2l * t.x, x1h * t.w + x2h * t.z); }
      qr[8 + k] = *reinterpret_cast<bf16x8*>(&oa); qr[10 + k] = *reinterpret_cast<bf16x8*>(&ob); } }
  const int sr = tid >> 4, sc = (tid & 15) * 8, vst0 = v_st(sr, sc), vst1 = v_st(32 + sr, sc);
  int krow[NKC], kcol[NKC];
#pragma unroll
  for (int i = 0; i < NKC; ++i) { const int c = tid + 512 * i; krow[i] = c / (DK / 8); kcol[i] = (c % (DK / 8)) * 8; }
  const int vb0 = (int)(uintptr_t)V_lds + v_rd_base(lane);
  struct { bf16x8 vs0, vs1, ks[NKC]; } sr_[SDEPTH];
#define SLOAD(i, k0) do { sr_[i].vs0 = ld8(&Vh[(long)((k0) + sr) * ldv + sc]); sr_[i].vs1 = ld8(&Vh[(long)((k0) + 32 + sr) * ldv + sc]); \
    _Pragma("unroll") for (int i_ = 0; i_ < NKC; ++i_) sr_[i].ks[i_] = ld8(&Kh[(long)((k0) + krow[i_]) * ldk + kcol[i_]]); } while (0)
#define SWRITE(b, i) do { *(bf16x8*)(V_lds + (b) * SHM_V + vst0) = sr_[i].vs0; *(bf16x8*)(V_lds + (b) * SHM_V + vst1) = sr_[i].vs1; \
    _Pragma("unroll") for (int i_ = 0; i_ < NKC; ++i_) *(bf16x8*)(K_lds + (b) * SHM_K + kswz<DK>(krow[i_], kcol[i_] * 2)) = sr_[i].ks[i_]; } while (0)
#define SWAIT() do { if constexpr (SDEPTH == 2) { if constexpr (NKC == 2) asm volatile("s_waitcnt vmcnt(4)" ::: "memory"); else asm volatile("s_waitcnt vmcnt(5)" ::: "memory"); } else asm volatile("s_waitcnt vmcnt(0)" ::: "memory"); } while (0)
#define RESC(a) do { if (__any((a) < 1.f)) { if (hi == 0) al_l[r32] = (a); asm volatile("s_waitcnt lgkmcnt(0)" ::: "memory"); \
    _Pragma("unroll") for (int d = 0; d < 4; ++d) _Pragma("unroll") for (int r = 0; r < 16; ++r) o[d][r] *= al_l[crow(r, hi)]; } } while (0)
  f32x16 pA0, pA1, pB0, pB1; float mnA, mnB, alA, alB; bf16x8 pa0, pa1, pa2, pa3; const int NT = seqr / KVBLK;
  constexpr int SE = 0, SO = SDEPTH - 1;
  SLOAD(SE, 0); asm volatile("s_waitcnt vmcnt(0)" ::: "memory"); SWRITE(0, SE); __syncthreads();
  qkt<DK>(pA0, pA1, K_lds, qr, r32, hi); partialSM(pA0, pA1, m_reg, mnA, alA, C, THRS);
  SLOAD(SO, KVBLK); if constexpr (SDEPTH == 2) { if (2 < NT) SLOAD(SE, 2 * KVBLK); }
  SWAIT(); SWRITE(1, SO); __syncthreads();
  for (int j = 1; j + 1 < NT; j += 2) {
    SBAR(); qkt<DK>(pB0, pB1, K_lds + SHM_K, qr, r32, hi);
    finishSM(pA0, pA1, alA, l_reg, pa0, pa1, pa2, pa3); SBAR();
    SLOAD(SO, (j + SDEPTH) * KVBLK); SBAR();
    pv_d0(o, vb0, pa0, pa1, pa2, pa3); partialSM(pB0, pB1, m_reg, mnB, alB, C, THRS);
    __syncthreads(); SWAIT(); SWRITE(0, SE);
    RESC(alB); __syncthreads();
    SBAR(); qkt<DK>(pA0, pA1, K_lds, qr, r32, hi);
    finishSM(pB0, pB1, alB, l_reg, pa0, pa1, pa2, pa3); SBAR();
    if (SDEPTH == 1 || j + 3 < NT) SLOAD(SE, (j + 1 + SDEPTH) * KVBLK); SBAR();
    pv_d0(o, vb0 + SHM_V, pa0, pa1, pa2, pa3); partialSM(pA0, pA1, m_reg, mnA, alA, C, THRS);
    __syncthreads(); SWAIT(); SWRITE(1, SO);
    RESC(alA); __syncthreads();
  }
  SBAR(); qkt<DK>(pB0, pB1, K_lds + SHM_K, qr, r32, hi);
  finishSM(pA0, pA1, alA, l_reg, pa0, pa1, pa2, pa3); SBAR();
  pv_d0(o, vb0, pa0, pa1, pa2, pa3); partialSM(pB0, pB1, m_reg, mnB, alB, C, THRS);
  __syncthreads(); RESC(alB);
  finishSM(pB0, pB1, alB, l_reg, pa0, pa1, pa2, pa3); SBAR();
  pv_d0(o, vb0 + SHM_V, pa0, pa1, pa2, pa3);
  if (hi == 0) li_l[r32] = l_reg; asm volatile("s_waitcnt lgkmcnt(0)" ::: "memory");
  float rli[16];
#pragma unroll
  for (int r = 0; r < 16; ++r) rli[r] = __builtin_amdgcn_rcpf(li_l[crow(r, hi)]);
  bf16* Ow = Ob + (long)(wid * QBLK) * ldo;
#pragma unroll
  for (int r = 0; r < 16; ++r) { int orow = crow(r, hi);
#pragma unroll
    for (int d0 = 0; d0 < 4; ++d0) Ow[(long)orow * ldo + d0 * 32 + r32] = (bf16)(cvtpk(o[d0][r] * rli[r], 0.f) & 0xffffu); }
  __syncthreads();
#undef SLOAD
#undef SWRITE
#undef SWAIT
#undef RESC
}

__device__ __forceinline__ void banded_wave_unit(const bf16* __restrict__ Q, long qs, const bf16* __restrict__ K, long ks, const bf16* __restrict__ V, long vs,
                                                 int i0, int L, bf16* __restrict__ O, long os, float* __restrict__ LSE, long ls, char* wlds) {
  constexpr float SCALE = 0.088388347648318440f, C = SCALE * 1.4426950408889634f;
  int tid_ = threadIdx.x; asm volatile("" : "+v"(tid_));
  const int lane = tid_ & 63, r32 = lane & 31, hi = lane >> 5;
  float* ex = (float*)(wlds + 8192);
  const int vb = (int)(uintptr_t)wlds + v_rd_base(lane);
  bf16x8 qr[8];
  { const bf16* Qw = Q + (long)(i0 + r32) * qs + hi * 8;
#pragma unroll
    for (int d0 = 0; d0 < 8; ++d0) qr[d0] = ld8(Qw + d0 * 16); }
  float m_reg = -1e30f, l_reg = 0.f; f32x16 o[4] = {};
  for (int tt = -2; tt <= 2; ++tt) {
    const int j0 = i0 + 32 * tt;
    if (j0 < 0 || j0 >= L) continue;
    bf16x8 vr[8], kf[8];
#pragma unroll
    for (int i = 0; i < 8; ++i) { const int idx = lane + 64 * i; vr[i] = ld8(V + (long)(j0 + (idx >> 4)) * vs + (idx & 15) * 8); }
    { const bf16* Kw = K + (long)(j0 + r32) * ks + hi * 8;
#pragma unroll
      for (int d0 = 0; d0 < 8; ++d0) kf[d0] = ld8(Kw + d0 * 16); }
    f32x16 p = f32x16{};
#pragma unroll
    for (int d0 = 0; d0 < 8; ++d0) p = __builtin_amdgcn_mfma_f32_32x32x16_bf16(kf[d0], qr[d0], p, 0, 0, 0);
    if (tt == -2) {
#pragma unroll
      for (int r = 0; r < 16; ++r) if (crow(r, hi) < r32) p[r] = -INFINITY; }
    if (tt == 2) {
#pragma unroll
      for (int r = 0; r < 16; ++r) if (crow(r, hi) > r32) p[r] = -INFINITY; }
    float pmax = p[0];
#pragma unroll
    for (int r = 1; r < 16; ++r) pmax = fmaxf(pmax, p[r]);
    { auto rr = __builtin_amdgcn_permlane32_swap(__float_as_uint(pmax), __float_as_uint(pmax), false, false);
      pmax = fmaxf(__uint_as_float(rr[0]), __uint_as_float(rr[1])); }
    const float mn = fmaxf(m_reg, pmax), alpha = __builtin_amdgcn_exp2f((m_reg - mn) * C); m_reg = mn;
    const float mnC = -mn * C; float ps = 0.f;
#pragma unroll
    for (int r = 0; r < 16; ++r) { p[r] = __builtin_amdgcn_exp2f(fmaf(p[r], C, mnC)); ps += p[r]; }
    { auto rr = __builtin_amdgcn_permlane32_swap(__float_as_uint(ps), __float_as_uint(ps), false, false);
      ps = __uint_as_float(rr[0]) + __uint_as_float(rr[1]); }
    l_reg = l_reg * alpha + ps;
    bf16x8 pa0, pa1; PK4(p, 0, pa0); PK4(p, 8, pa1);
    if (hi == 0) ex[r32] = alpha;
#pragma unroll
    for (int i = 0; i < 8; ++i) { const int idx = lane + 64 * i; *(bf16x8*)(wlds + v_st(idx >> 4, (idx & 15) * 8)) = vr[i]; }
    asm volatile("s_waitcnt lgkmcnt(0)" ::: "memory"); SBAR();
#pragma unroll
    for (int d = 0; d < 4; ++d)
#pragma unroll
      for (int r = 0; r < 16; ++r) o[d][r] *= ex[crow(r, hi)];
#define PV2(D0) do { const s16x4 l0 = tr_read<v_rd_off(D0, 0, 0)>(vb), h0 = tr_read<v_rd_off(D0, 0, 1)>(vb), l1 = tr_read<v_rd_off(D0, 1, 0)>(vb), h1 = tr_read<v_rd_off(D0, 1, 1)>(vb); \
      asm volatile("s_waitcnt lgkmcnt(0)" ::: "memory"); SBAR(); \
      o[D0] = __builtin_amdgcn_mfma_f32_32x32x16_bf16(pa0, PKV(l0, h0), o[D0], 0, 0, 0); \
      o[D0] = __builtin_amdgcn_mfma_f32_32x32x16_bf16(pa1, PKV(l1, h1), o[D0], 0, 0, 0); } while (0)
    PV2(0); PV2(1); PV2(2); PV2(3);
#undef PV2
    asm volatile("s_waitcnt lgkmcnt(0)" ::: "memory"); SBAR();
  }
  if (hi == 0) { ex[32 + r32] = l_reg; LSE[(long)(i0 + r32) * ls] = m_reg * SCALE + __logf(l_reg); }
  asm volatile("s_waitcnt lgkmcnt(0)" ::: "memory"); SBAR();
  float rli[16];
#pragma unroll
  for (int r = 0; r < 16; ++r) rli[r] = __builtin_amdgcn_rcpf(ex[32 + crow(r, hi)]);
#pragma unroll
  for (int r = 0; r < 16; ++r) { const int orow = crow(r, hi);
#pragma unroll
    for (int d0 = 0; d0 < 4; ++d0) O[(long)(i0 + orow) * os + d0 * 32 + r32] = (bf16)(cvtpk(o[d0][r] * rli[r], 0.f) & 0xffffu); }
  asm volatile("s_waitcnt lgkmcnt(0)" ::: "memory"); SBAR();
}
#undef PK4
#undef PKV
#undef SBAR
}
#define LAS __attribute__((address_space(3)))
typedef unsigned short bf16;
typedef unsigned v4u __attribute__((ext_vector_type(4)));
typedef unsigned v2u __attribute__((ext_vector_type(2)));
typedef float f32x4 __attribute__((ext_vector_type(4)));

constexpr int NB = 4, SEQ = 2048, T = NB * SEQ, DM = 2048, DEPTH = 2;
constexpr int NIN = 4928, NINP = 5120, NUQ = 1152, NUQP = 1280, NUKV = 1536, DFF = 5632, NUP = 2 * DFF, CQR = 512;
constexpr int AQ_OFF = 0, AK_OFF = 768, AV_OFF = 1024, BQ_OFF = 1280, BK_OFF = 2816, BV_OFF = 3328, CQ_OFF = 3840, CKV_OFF = 4352, CKR_OFF = 4864;
constexpr float EPS = 1e-6f;
constexpr int NWAVES = 8, NTHR = 512;
constexpr int LDS_BYTES = 147456;

constexpr size_t MiB = 1u << 20;
constexpr size_t SZ_WIN = (size_t)NINP * DM * 2, SZ_WUQ = (size_t)NUQP * CQR * 2, SZ_WUKV = (size_t)NUKV * CQR * 2, SZ_WOUT = (size_t)DM * DM * 2, SZ_WUP = (size_t)NUP * DM * 2, SZ_WDN = (size_t)DM * DFF * 2;
constexpr size_t WL_IN = 0, WL_UQ = WL_IN + SZ_WIN, WL_UKV = WL_UQ + SZ_WUQ, WL_OUT = WL_UKV + SZ_WUKV, WL_UP = WL_OUT + SZ_WOUT, WL_DN = WL_UP + SZ_WUP, WL_SIZE = WL_DN + SZ_WDN;
constexpr size_t WS_TAB = 1 * MiB;
constexpr int TAB_ROW = 0, TAB_COL = 32 * 32, TAB_PART = TAB_COL + 64 * 32, TAB_MLA = TAB_PART + SEQ * 16, TAB_N = TAB_MLA + SEQ * 32;
constexpr size_t WS_W = 2 * MiB;
constexpr size_t CTL_ZERO_BYTES = 65536;
constexpr int CW_BAR = 1024, LDS_MISC_OFF = 131072 + 1024, LDS_ARG_OFF = 131072 + 512;
constexpr size_t WS_XN = WS_W + 2 * WL_SIZE;
constexpr size_t WS_X = WS_XN + (size_t)T * DM * 2;
constexpr size_t WS_R1 = WS_X + (size_t)T * DM * 4;
constexpr size_t WS_PROJ = WS_R1;
constexpr size_t WS_QC = WS_PROJ + (size_t)T * NINP * 2;
constexpr size_t WS_KC = WS_QC + (size_t)T * NUQ * 2;
constexpr size_t WS_VC = WS_KC + (size_t)T * NUQ * 2;
constexpr size_t WS_OB = WS_VC + (size_t)T * 768 * 2;
constexpr size_t WS_LSE = WS_OB + (size_t)3 * T * 512 * 4;
constexpr size_t WS_R1_END = WS_LSE + (size_t)3 * T * 4 * 4;
constexpr size_t WS_H = WS_R1;
constexpr size_t WS_H_END = WS_H + (size_t)T * NUP * 2;
constexpr size_t WS_R2 = (WS_R1_END > WS_H_END ? WS_R1_END : WS_H_END);
constexpr size_t WS_Y = WS_R2;
constexpr size_t WS_YN = WS_Y + (size_t)T * DM * 4;
constexpr size_t WS_ACT = WS_R2;
constexpr size_t WS_X2 = WS_YN + (size_t)T * DM * 2;
constexpr size_t WS_HB = WS_X2 + (size_t)T * DM * 4;
constexpr size_t WS_END = WS_HB + (size_t)(T / 256) * 4 * NUP * 4;
static_assert((size_t)T * DFF * 2 <= (size_t)T * DM * 6, "ACT fits over Y|YN");
static_assert((size_t)TAB_N * 8 <= MiB, "tables fit");
static_assert(WS_W % 256 == 0 && WL_SIZE % 256 == 0 && WS_R2 % 256 == 0, "alignment");

struct Args {
    const float *x, *attn_norm, *w_in, *a_q_norm, *a_k_norm, *c_q_norm, *c_kv_norm, *w_uq, *w_ukv, *out_norm, *w_out, *ffn_norm, *w_up, *conv_w, *conv_b, *w_down, *final_norm;
    float* out; unsigned char* ws; int ph_lo, ph_hi;
};

__device__ __forceinline__ unsigned f2bf(float f) { unsigned u = __builtin_bit_cast(unsigned, f); return (u + 0x7fffu + ((u >> 16) & 1u)) >> 16; }
__device__ __forceinline__ unsigned pk2(float lo, float hi) { return f2bf(lo) | (f2bf(hi) << 16); }
__device__ __forceinline__ float bf2f(unsigned short h) { return __builtin_bit_cast(float, (unsigned)h << 16); }
__device__ __forceinline__ float bflo(unsigned w) { return __builtin_bit_cast(float, w << 16); }
__device__ __forceinline__ float bfhi(unsigned w) { return __builtin_bit_cast(float, w & 0xffff0000u); }
__device__ __forceinline__ float wave_sum(float v) {
#pragma unroll
    for (int o = 1; o < 64; o <<= 1) v += __shfl_xor(v, o);
    return v;
}

template <bool FFN_PERM = false>
__device__ __forceinline__ void p0_transpose_item(const float* W, int K, int N, bf16* WT, float*  , int item, int lane) {
    const int nblk = N / 64, kb0 = item / nblk, nb = item % nblk, k0 = 64 * kb0, n0 = 64 * nb, kb = lane >> 4, nq = lane & 15;
    const int d0 = FFN_PERM ? (256 * ((n0 % DFF) / 128) + 128 * (n0 / DFF) + (n0 % DFF) % 128) : n0;
    const float* src = W + (size_t)(k0 + 8 * kb) * N + n0 + 4 * nq;
    bf16* dst = WT + (size_t)(d0 + 4 * nq) * K + k0 + 8 * kb;
#pragma unroll
    for (int h = 0; h < 2; ++h) {
        f32x4 v[8];
#pragma unroll
        for (int j = 0; j < 8; ++j) v[j] = __builtin_nontemporal_load((const f32x4*)(src + (size_t)(32 * h + j) * N));
#pragma unroll
        for (int i = 0; i < 4; ++i) { v4u o; o.x = pk2(v[0][i], v[1][i]); o.y = pk2(v[2][i], v[3][i]); o.z = pk2(v[4][i], v[5][i]); o.w = pk2(v[6][i], v[7][i]);
            *(v4u*)(dst + (size_t)i * K + 32 * h) = o; }
    }
}
__device__ __forceinline__ void convert_out(const float* w_out, unsigned char* wb, int sub_w, int sub_n, int lane) {
    constexpr int I_OUT = (DM / 64) * (DM / 64);
    for (int it = sub_w; it < I_OUT; it += sub_n) p0_transpose_item(w_out, DM, DM, (bf16*)(wb + WL_OUT), nullptr, it, lane);
}
__device__ __forceinline__ void convert_ffn(const float* w_up, const float* w_down, unsigned char* wb, int sub_w, int sub_n, int lane) {
    constexpr int I_UP = (DM / 64) * (NUP / 64), I_DN = (DFF / 64) * (DM / 64);
    for (int it = sub_w; it < I_UP + I_DN; it += sub_n) {
        if (it < I_UP) p0_transpose_item<true>(w_up, DM, NUP, (bf16*)(wb + WL_UP), nullptr, it, lane);
        else p0_transpose_item(w_down, DFF, DM, (bf16*)(wb + WL_DN), nullptr, it - I_UP, lane); }
}
__device__ __forceinline__ void rms_row_bf16(const float* xrow, const float* g, bf16* orow, int lane) {
    const f32x4* xr = (const f32x4*)xrow + lane; const f32x4* gr = (const f32x4*)g + lane;
    f32x4 v[8]; float s = 0.f;
#pragma unroll
    for (int j = 0; j < 8; ++j) { v[j] = __builtin_nontemporal_load(xr + 64 * j); s += (v[j].x * v[j].x + v[j].y * v[j].y) + (v[j].z * v[j].z + v[j].w * v[j].w); }
    const float rstd = 1.f / sqrtf(wave_sum(s) * (1.f / DM) + EPS);
    v2u* o8 = (v2u*)orow + lane;
#pragma unroll
    for (int j = 0; j < 8; ++j) { const f32x4 gg = gr[64 * j]; v2u w; w.x = pk2(v[j].x * rstd * gg.x, v[j].y * rstd * gg.y); w.y = pk2(v[j].z * rstd * gg.z, v[j].w * rstd * gg.w); o8[64 * j] = w; }
}
__device__ __forceinline__ void rms_row_f32(const float* xrow, const float* g, float* orow, int lane) {
    const f32x4* xr = (const f32x4*)xrow + lane; const f32x4* gr = (const f32x4*)g + lane;
    f32x4 v[8]; float s = 0.f;
#pragma unroll
    for (int j = 0; j < 8; ++j) { v[j] = xr[64 * j]; s += (v[j].x * v[j].x + v[j].y * v[j].y) + (v[j].z * v[j].z + v[j].w * v[j].w); }
    const float rstd = 1.f / sqrtf(wave_sum(s) * (1.f / DM) + EPS);
    f32x4* o = (f32x4*)orow + lane;
#pragma unroll
    for (int j = 0; j < 8; ++j) { const f32x4 gg = gr[64 * j]; o[64 * j] = v[j] * rstd * gg; }
}
__device__ __forceinline__ void rmsb_row(const bf16* xrow, const float* g, bf16* obf, float* of32, int lane) {
    const v4u* xr = (const v4u*)xrow + lane; float f[4][8]; float s = 0.f;
#pragma unroll
    for (int j = 0; j < 4; ++j) { const v4u r = xr[64 * j]; f[j][0] = bflo(r.x); f[j][1] = bfhi(r.x); f[j][2] = bflo(r.y); f[j][3] = bfhi(r.y); f[j][4] = bflo(r.z); f[j][5] = bfhi(r.z); f[j][6] = bflo(r.w); f[j][7] = bfhi(r.w);
#pragma unroll
        for (int e = 0; e < 8; ++e) s += f[j][e] * f[j][e]; }
    const float rstd = 1.f / sqrtf(wave_sum(s) * (1.f / DM) + EPS);
#pragma unroll
    for (int j = 0; j < 4; ++j) { const int c = (lane + 64 * j) * 8; const f32x4 g0 = *(const f32x4*)(g + c), g1 = *(const f32x4*)(g + c + 4);
        const float y0 = f[j][0] * rstd * g0.x, y1 = f[j][1] * rstd * g0.y, y2 = f[j][2] * rstd * g0.z, y3 = f[j][3] * rstd * g0.w, y4 = f[j][4] * rstd * g1.x, y5 = f[j][5] * rstd * g1.y, y6 = f[j][6] * rstd * g1.z, y7 = f[j][7] * rstd * g1.w;
        if (obf) { v4u w; w.x = pk2(y0, y1); w.y = pk2(y2, y3); w.z = pk2(y4, y5); w.w = pk2(y6, y7); *(v4u*)(obf + c) = w; }
        else { __builtin_nontemporal_store((f32x4){y0, y1, y2, y3}, (f32x4*)(of32 + c)); __builtin_nontemporal_store((f32x4){y4, y5, y6, y7}, (f32x4*)(of32 + c + 4)); } }
}
__device__ __forceinline__ float inv_freq(float theta, int j2, int dim) { return powf(theta, -(float)j2 / (float)dim); }

__device__ __forceinline__ void unpack8(const v4u r, float* f) { f[0] = bflo(r.x); f[1] = bfhi(r.x); f[2] = bflo(r.y); f[3] = bfhi(r.y); f[4] = bflo(r.z); f[5] = bfhi(r.z); f[6] = bflo(r.w); f[7] = bfhi(r.w); }
typedef float f32x2 __attribute__((ext_vector_type(2)));
__device__ __forceinline__ v4u rope8(const float* y, const float* yp, bool first, const f32x2* cs) {
    float o[8];
#pragma unroll
    for (int e = 0; e < 8; ++e) { const f32x2 t = cs[e]; o[e] = first ? (y[e] * t.x - yp[e] * t.y) : (yp[e] * t.y + y[e] * t.x); }
    v4u w; w.x = pk2(o[0], o[1]); w.y = pk2(o[2], o[3]); w.z = pk2(o[4], o[5]); w.w = pk2(o[6], o[7]); return w;
}
__device__ __forceinline__ void prep_row(bf16* P, bf16* KCrow, int s, const float* aqn, const float* akn, const float* cqn, const float* ckvn, const f32x2* tab, int lane) {
    { const int l16 = lane & 15, hsel = lane >> 4; const bool first = (l16 & 4) == 0;
      const f32x2* cs = tab + ((l16 < 8) ? (TAB_ROW + (s / 64) * 32) : (TAB_COL + (s % 64) * 32)) + (l16 & 3) * 8;
#pragma unroll
      for (int it = 0; it < 2; ++it) { const int hh = it * 4 + hsel; bf16* hp = P + AQ_OFF + hh * 128 + l16 * 8; const float* g = ((hh < 6) ? aqn : akn) + l16 * 8;
          float f[8], y[8], yp[8]; unpack8(*(const v4u*)hp, f);
          float ss = 0.f;
#pragma unroll
          for (int e = 0; e < 8; ++e) ss += f[e] * f[e];
          ss += __shfl_xor(ss, 1); ss += __shfl_xor(ss, 2); ss += __shfl_xor(ss, 4); ss += __shfl_xor(ss, 8);
          const float rstd = 1.f / sqrtf(ss * (1.f / 128.f) + EPS);
#pragma unroll
          for (int e = 0; e < 8; ++e) { y[e] = f[e] * rstd * g[e]; yp[e] = __shfl_xor(y[e], 4); }
          *(v4u*)hp = rope8(y, yp, first, cs); } }
    { const int hh = lane >> 2, cq = lane & 3; const bool first = cq < 2; bf16* hp = P + BQ_OFF + hh * 128 + cq * 8;
      const f32x2* cs = tab + TAB_PART + s * 16 + (cq & 1) * 8;
      float y[8], yp[8]; unpack8(*(const v4u*)hp, y);
#pragma unroll
      for (int e = 0; e < 8; ++e) yp[e] = __shfl_xor(y[e], 2);
      *(v4u*)hp = rope8(y, yp, first, cs); }
#pragma unroll
    for (int w = 0; w < 2; ++w) { bf16* lp = P + (w == 0 ? CQ_OFF : CKV_OFF) + lane * 8; const float* g = (w == 0 ? cqn : ckvn) + lane * 8;
        float f[8]; unpack8(*(const v4u*)lp, f);
        float ss = 0.f;
#pragma unroll
        for (int e = 0; e < 8; ++e) ss += f[e] * f[e];
        const float rstd = 1.f / sqrtf(wave_sum(ss) * (1.f / 512.f) + EPS);
        v4u o; o.x = pk2(f[0] * rstd * g[0], f[1] * rstd * g[1]); o.y = pk2(f[2] * rstd * g[2], f[3] * rstd * g[3]); o.z = pk2(f[4] * rstd * g[4], f[5] * rstd * g[5]); o.w = pk2(f[6] * rstd * g[6], f[7] * rstd * g[7]);
        *(v4u*)lp = o; }
    { const int l8 = lane & 7; const bool first = l8 < 4; bf16* kp = P + CKR_OFF + l8 * 8; const f32x2* cs = tab + TAB_MLA + s * 32 + (l8 & 3) * 8;
      float y[8], yp[8]; unpack8(*(const v4u*)kp, y);
#pragma unroll
      for (int e = 0; e < 8; ++e) yp[e] = __shfl_xor(y[e], 4);
      const v4u w = rope8(y, yp, first, cs);
      if (lane < 8) { *(v4u*)kp = w;
#pragma unroll
          for (int h = 0; h < 6; ++h) *(v4u*)(KCrow + h * 192 + 128 + l8 * 8) = w; } }
}
__device__ __forceinline__ f32x4 ldbf4(const bf16* p) { const v2u r = *(const v2u*)p; return (f32x4){bflo(r.x), bfhi(r.x), bflo(r.y), bfhi(r.y)}; }
__device__ __forceinline__ void outnorm_row(const bf16* Yrow, const bf16* OB, const float* LSE, int t, const float* g, bf16* YNrow, int lane) {
    f32x4 a[3], c[3], b[2];
    float sa = 0.f, sb = 0.f, scc = 0.f;
#pragma unroll
    for (int k = 0; k < 3; ++k) { a[k] = ldbf4(Yrow + (lane + 64 * k) * 4); sa += (a[k].x * a[k].x + a[k].y * a[k].y) + (a[k].z * a[k].z + a[k].w * a[k].w);
                                  c[k] = ldbf4(Yrow + 1280 + (lane + 64 * k) * 4); scc += (c[k].x * c[k].x + c[k].y * c[k].y) + (c[k].z * c[k].z + c[k].w * c[k].w); }
#pragma unroll
    for (int k = 0; k < 2; ++k) { const int idx = lane + 64 * k, h = idx >> 5;
        const float l0 = LSE[((size_t)0 * T + t) * 4 + h], l1 = LSE[((size_t)1 * T + t) * 4 + h], l2 = LSE[((size_t)2 * T + t) * 4 + h];
        const float mx = fmaxf(l0, fmaxf(l1, l2)); const float e0 = __expf(l0 - mx), e1 = __expf(l1 - mx), e2 = __expf(l2 - mx); const float inv = 1.f / (e0 + e1 + e2);
        const f32x4 o0 = ldbf4(OB + ((size_t)0 * T + t) * 512 + idx * 4), o1 = ldbf4(OB + ((size_t)1 * T + t) * 512 + idx * 4), o2 = ldbf4(OB + ((size_t)2 * T + t) * 512 + idx * 4);
        b[k] = o0 * (e0 * inv) + o1 * (e1 * inv) + o2 * (e2 * inv);
        sb += (b[k].x * b[k].x + b[k].y * b[k].y) + (b[k].z * b[k].z + b[k].w * b[k].w); }
    const float ra = 1.f / sqrtf(wave_sum(sa) * (1.f / 768.f) + EPS), rb = 1.f / sqrtf(wave_sum(sb) * (1.f / 512.f) + EPS), rc = 1.f / sqrtf(wave_sum(scc) * (1.f / 768.f) + EPS);
#pragma unroll
    for (int k = 0; k < 3; ++k) { const int idx = lane + 64 * k; const f32x4 ga = ((const f32x4*)g)[idx], gc = ((const f32x4*)(g + 1280))[idx];
        v2u w; w.x = pk2(a[k].x * ra * ga.x, a[k].y * ra * ga.y); w.y = pk2(a[k].z * ra * ga.z, a[k].w * ra * ga.w); ((v2u*)YNrow)[idx] = w;
        v2u w2; w2.x = pk2(c[k].x * rc * gc.x, c[k].y * rc * gc.y); w2.y = pk2(c[k].z * rc * gc.z, c[k].w * rc * gc.w); ((v2u*)(YNrow + 1280))[idx] = w2; }
#pragma unroll
    for (int k = 0; k < 2; ++k) { const int idx = lane + 64 * k; const f32x4 gb = ((const f32x4*)(g + 768))[idx];
        v2u w; w.x = pk2(b[k].x * rb * gb.x, b[k].y * rb * gb.y); w.y = pk2(b[k].z * rb * gb.z, b[k].w * rb * gb.w); ((v2u*)(YNrow + 768))[idx] = w; }
}
constexpr int CONV_R = 16;
__device__ __forceinline__ void convact_item(const bf16* H, const float* cw, const float* cb, bf16* ACT, int t0, int c8) {
    const int c = c8 * 8, s0 = t0 % SEQ;
    float wg[3][8], wu[3][8], bg[8], bu[8];
#pragma unroll
    for (int k = 0; k < 3; ++k) { const f32x4 a0 = *(const f32x4*)(cw + (size_t)k * NUP + c), a1 = *(const f32x4*)(cw + (size_t)k * NUP + c + 4), b0 = *(const f32x4*)(cw + (size_t)k * NUP + DFF + c), b1 = *(const f32x4*)(cw + (size_t)k * NUP + DFF + c + 4);
        wg[k][0] = a0.x; wg[k][1] = a0.y; wg[k][2] = a0.z; wg[k][3] = a0.w; wg[k][4] = a1.x; wg[k][5] = a1.y; wg[k][6] = a1.z; wg[k][7] = a1.w;
        wu[k][0] = b0.x; wu[k][1] = b0.y; wu[k][2] = b0.z; wu[k][3] = b0.w; wu[k][4] = b1.x; wu[k][5] = b1.y; wu[k][6] = b1.z; wu[k][7] = b1.w; }
    { const f32x4 a0 = *(const f32x4*)(cb + c), a1 = *(const f32x4*)(cb + c + 4), b0 = *(const f32x4*)(cb + DFF + c), b1 = *(const f32x4*)(cb + DFF + c + 4);
      bg[0] = a0.x; bg[1] = a0.y; bg[2] = a0.z; bg[3] = a0.w; bg[4] = a1.x; bg[5] = a1.y; bg[6] = a1.z; bg[7] = a1.w;
      bu[0] = b0.x; bu[1] = b0.y; bu[2] = b0.z; bu[3] = b0.w; bu[4] = b1.x; bu[5] = b1.y; bu[6] = b1.z; bu[7] = b1.w; }
    const bf16* hp = H + (size_t)t0 * NUP + c;
    v4u pg, pu, cg_, cu, ng, nu;
    const v4u z = (v4u){0u, 0u, 0u, 0u};
    if (s0 > 0) { pg = *(const v4u*)(hp - NUP); pu = *(const v4u*)(hp - NUP + DFF); } else { pg = z; pu = z; }
    cg_ = *(const v4u*)hp; cu = *(const v4u*)(hp + DFF);
#pragma unroll 4
    for (int r = 0; r < CONV_R; ++r) {
        if (s0 + r + 1 < SEQ) { ng = *(const v4u*)(hp + (size_t)(r + 1) * NUP); nu = *(const v4u*)(hp + (size_t)(r + 1) * NUP + DFF); } else { ng = z; nu = z; }
        float a0[8], a1[8], a2[8], b0[8], b1[8], b2[8], o[8];
        unpack8(pg, a0); unpack8(cg_, a1); unpack8(ng, a2); unpack8(pu, b0); unpack8(cu, b1); unpack8(nu, b2);
#pragma unroll
        for (int e = 0; e < 8; ++e) { const float g = bg[e] + wg[0][e] * a0[e] + wg[1][e] * a1[e] + wg[2][e] * a2[e], u = bu[e] + wu[0][e] * b0[e] + wu[1][e] * b1[e] + wu[2][e] * b2[e];
            o[e] = g / (1.f + __expf(-g)) * u; }
        v4u w; w.x = pk2(o[0], o[1]); w.y = pk2(o[2], o[3]); w.z = pk2(o[4], o[5]); w.w = pk2(o[6], o[7]);
        *(v4u*)(ACT + (size_t)(t0 + r) * DFF + c) = w;
        pg = cg_; pu = cu; cg_ = ng; cu = nu;
    }
}

#define XB_TMO      128
#define XB_XCNT(j)  (256  + 64 * (j))
#define XB_XSUB(j)  (1280 + 64 * (j))
#define XB_XGEN(j)  (2304 + 64 * (j))
#define XB_TOP      3328
#define XB_TOPGEN   3392
#define XCD_BAR_WORDS 3456
#define XB_SPIN_CAP (1u << 18)

__device__ __forceinline__ unsigned xb_ld(unsigned* p)              { return __hip_atomic_load(p, __ATOMIC_RELAXED, __HIP_MEMORY_SCOPE_AGENT); }
__device__ __forceinline__ unsigned xb_add(unsigned* p, unsigned v) { return __hip_atomic_fetch_add(p, v, __ATOMIC_RELAXED, __HIP_MEMORY_SCOPE_AGENT); }
__device__ __forceinline__ unsigned xb_xcc_id() { return (unsigned)__builtin_amdgcn_s_getreg((3 << 11) | 20) & 0xFu; }
#define XB_SPIN(cond, bar) do { unsigned _sp = 0; while (cond) { __builtin_amdgcn_s_sleep(1); \
    if ((++_sp & 255u) == 0u) { if (xb_ld(&(bar)[XB_TMO])) break; if (_sp > XB_SPIN_CAP) { atomicAdd(&(bar)[XB_TMO], 1u); break; } } } } while (0)

struct XcdBarrier {
    unsigned* bar; unsigned x;
    volatile LAS unsigned* st;
};

__device__ __forceinline__ XcdBarrier xcd_barrier_post(unsigned* bar, volatile LAS unsigned* st) {
    XcdBarrier b; b.bar = bar; b.x = xb_xcc_id(); b.st = st;
    if (threadIdx.x == 0) (void)xb_add(&bar[XB_XCNT(b.x)], 1u);
    return b;
}
__device__ __forceinline__ void xcd_barrier_complete(unsigned* bar, unsigned x, unsigned& nloc, unsigned& nx) {
    const unsigned G = gridDim.x * gridDim.y * gridDim.z;
    unsigned sum, cnt, mine, sp = 0u;
    for (;;) {
        sum = 0u; cnt = 0u; mine = 0u;
#pragma unroll
        for (unsigned j = 0; j < 16; ++j) { const unsigned c = xb_ld(&bar[XB_XCNT(j)]); sum += c; cnt += (c > 0u) ? 1u : 0u; mine = (j == x) ? c : mine; }
        if (sum == G) break;
        __builtin_amdgcn_s_sleep(1);
        if ((++sp & 255u) == 0u) { if (xb_ld(&bar[XB_TMO])) break; if (sp > XB_SPIN_CAP) { atomicAdd(&bar[XB_TMO], 1u); break; } }
    }
    nloc = mine > 0u ? mine : 1u; nx = cnt > 0u ? cnt : 1u;
}

__device__ __forceinline__ void xcd_barrier(const XcdBarrier& b) {
    asm volatile("s_waitcnt vmcnt(0)" ::: "memory");
    __syncthreads();
    if (threadIdx.x == 0) {
        unsigned* bar = b.bar;
        __builtin_amdgcn_s_waitcnt(0);
        unsigned nloc = b.st[0], nx = b.st[1];
        if (nloc == 0u) { xcd_barrier_complete(bar, b.x, nloc, nx); b.st[0] = nloc; b.st[1] = nx; }
        const unsigned old = xb_add(&bar[XB_XSUB(b.x)], 1u);
        const unsigned gen = old / nloc;
        if (old + 1u == (gen + 1u) * nloc) {
            __builtin_amdgcn_fence(__ATOMIC_RELEASE, "agent");
            asm volatile("s_waitcnt vmcnt(0)" ::: "memory");
            const unsigned og = xb_add(&bar[XB_TOP], 1u);
            const unsigned tg = og / nx;
            if (og + 1u == (tg + 1u) * nx) xb_add(&bar[XB_TOPGEN], 1u);
            else XB_SPIN(xb_ld(&bar[XB_TOPGEN]) == tg, bar);
            __builtin_amdgcn_fence(__ATOMIC_ACQUIRE, "agent");
            xb_add(&bar[XB_XGEN(b.x)], 1u);
            asm volatile("s_waitcnt vmcnt(0)" ::: "memory");
        } else {
            XB_SPIN(xb_ld(&bar[XB_XGEN(b.x)]) == gen, bar);
            __builtin_amdgcn_fence(__ATOMIC_ACQUIRE, "agent");
            asm volatile("s_waitcnt vmcnt(0)" ::: "memory");
        }
    }
    __syncthreads();
}

__device__ __forceinline__ const float* ldarg(const LAS unsigned long long* t, int i) { const unsigned long long v = t[i];
    const unsigned lo = __builtin_amdgcn_readfirstlane((unsigned)v), hi = __builtin_amdgcn_readfirstlane((unsigned)(v >> 32)); return (const float*)(((unsigned long long)hi << 32) | lo); }
constexpr int NPL = 11, NPLX = NPL + 1, NPH = NPLX * DEPTH;
#ifndef USE_CG_SYNC
#define GRID_BAR() xcd_barrier(xbar)
#else
#define GRID_BAR() grid.sync()
#endif
#ifndef PH_MASK
#define PH_MASK 0xffff
#endif
#define PH_EN(k) (((PH_MASK) >> (k)) & 1)
#ifndef ATT_MASK
#define ATT_MASK 15
#endif
#ifndef SD128
#define SD128 2
#endif
#ifndef SD192
#define SD192 1
#endif
#ifndef NQR128
#define NQR128 4
#endif
#ifndef NQR192
#define NQR192 4
#endif
#ifndef ATTV128
#define ATTV128 0
#endif
#ifndef ATTV192
#define ATTV192 0
#endif
#if ATTV128 == 0
#define ATTN128 att::attn_dense_unit<128, NINP, NINP, NINP, DM>
#else
#define ATTN128 att::attn_dense_unit2<128, ATTV128, NINP, NINP, NINP, DM>
#endif
#if ATTV192 == 0
#define ATTN192 att::attn_dense_unit<192, NUQ, NUQ, 768, DM>
#else
#define ATTN192 att::attn_dense_unit2<192, ATTV192, NUQ, NUQ, 768, DM>
#endif
#define ATT_EN(k) (((amask) >> (k)) & 1)

__global__ void __launch_bounds__(NTHR, 2) fwd(Args a) {
    extern __shared__ __attribute__((aligned(16))) unsigned char lds[];
    cg::grid_group grid = cg::this_grid();
    { volatile LAS unsigned long long* at = (volatile LAS unsigned long long*)((LAS unsigned char*)lds + LDS_ARG_OFF);
      if (threadIdx.x == 0) { at[0] = (unsigned long long)a.x; at[1] = (unsigned long long)a.attn_norm; at[2] = (unsigned long long)a.w_in; at[3] = (unsigned long long)a.a_q_norm; at[4] = (unsigned long long)a.a_k_norm;
          at[5] = (unsigned long long)a.c_q_norm; at[6] = (unsigned long long)a.c_kv_norm; at[7] = (unsigned long long)a.w_uq; at[8] = (unsigned long long)a.w_ukv; at[9] = (unsigned long long)a.out_norm;
          at[10] = (unsigned long long)a.w_out; at[11] = (unsigned long long)a.ffn_norm; at[12] = (unsigned long long)a.w_up; at[13] = (unsigned long long)a.conv_w; at[14] = (unsigned long long)a.conv_b;
          at[15] = (unsigned long long)a.w_down; at[16] = (unsigned long long)a.final_norm; at[17] = (unsigned long long)a.out; at[18] = (unsigned long long)a.ws; } }
#define AP(i) ldarg((const LAS unsigned long long*)((LAS unsigned char*)lds + LDS_ARG_OFF), (i))
    const int G = gridDim.x, bx = blockIdx.x;
    const int NGW = G * NWAVES;
#define XN ((bf16*)(ws + WS_XN))
#define X ((bf16*)(ws + WS_X))
#define X2 ((bf16*)(ws + WS_X2))
#define PROJ ((bf16*)(ws + WS_PROJ))
#define QC ((bf16*)(ws + WS_QC))
#define KC ((bf16*)(ws + WS_KC))
#define VC ((bf16*)(ws + WS_VC))
#define OB ((bf16*)(ws + WS_OB))
#define LSE ((float*)(ws + WS_LSE))
#define H ((bf16*)(ws + WS_H))
#define Y ((bf16*)(ws + WS_Y))
#define YN ((bf16*)(ws + WS_YN))
#define ACT ((bf16*)(ws + WS_ACT))

    volatile LAS unsigned* xst = (volatile LAS unsigned*)((LAS unsigned char*)lds + LDS_MISC_OFF);
    if (threadIdx.x < 4) xst[threadIdx.x] = 0u;
    __syncthreads();
    XcdBarrier xbar = xcd_barrier_post((unsigned*)a.ws + CW_BAR, xst);
    if (a.ph_lo < 0) grid.sync();
#ifdef DIAG_A
    if (bx == 0 && threadIdx.x == 0) ((unsigned long long*)ws)[16 + a.ph_lo] = __builtin_amdgcn_s_memrealtime();
#endif
#ifdef REP_PH
    constexpr int REP_LEN = REP_PH2 - REP_PH + 1, REP_X = REP_N * REP_LEN;
    for (int it_ = a.ph_lo; it_ < a.ph_hi + REP_X; ++it_) { const int ph = (it_ <= REP_PH2) ? it_ : ((it_ <= REP_PH2 + REP_X) ? REP_PH + (it_ - REP_PH2 - 1) % REP_LEN : it_ - REP_X);
#else
    for (int ph = a.ph_lo; ph < a.ph_hi; ++ph) {
#endif
        int tid_ = threadIdx.x; asm volatile("" : "+v"(tid_));
#if defined(REP_PH) && defined(REP_ATT_MASK)
        const int amask = (it_ > REP_PH2 && it_ <= REP_PH2 + REP_X) ? (REP_ATT_MASK) : (ATT_MASK);
#else
        const int amask = ATT_MASK;
#endif
        const int tid = tid_, lane = tid & 63, wave = __builtin_amdgcn_readfirstlane(tid >> 6);
        unsigned char* const ws = (unsigned char*)AP(18);
        const int gw = bx * NWAVES + wave;
        const int l = ph / NPLX, k = ph % NPLX - 1;
        unsigned char* wl = ws + WS_W + (size_t)l * WL_SIZE;
        if (k < 0 && PH_EN(12)) {
            float* scr = (float*)(lds + wave * 16384);
            constexpr int I_IN = (DM / 64) * (NIN / 64), I_UQ = (CQR / 64) * (NUQ / 64), I_UKV = (CQR / 64) * (NUKV / 64), I_OUT = (DM / 64) * (DM / 64), I_UP = (DM / 64) * (NUP / 64), I_DN = (DFF / 64) * (DM / 64);
            constexpr int I_L = I_IN + I_UQ + I_UKV;
            for (int it = gw; it < I_L; it += NGW) {
                const int ll = l; int r = it; unsigned char* wb = wl;
                if (r < I_IN) { p0_transpose_item(AP(2) + (size_t)ll * DM * NIN, DM, NIN, (bf16*)(wb + WL_IN), scr, r, lane); continue; } r -= I_IN;
                if (r < I_UQ) { p0_transpose_item(AP(7) + (size_t)ll * CQR * NUQ, CQR, NUQ, (bf16*)(wb + WL_UQ), scr, r, lane); continue; } r -= I_UQ;
                p0_transpose_item(AP(8) + (size_t)ll * CQR * NUKV, CQR, NUKV, (bf16*)(wb + WL_UKV), scr, r, lane);
            }
            { unsigned char* wb = wl;
                v4u* z1 = (v4u*)(wb + WL_IN + (size_t)NIN * DM * 2); const int n1 = (NINP - NIN) * DM * 2 / 16;
                for (int i = bx * NTHR + tid; i < n1; i += G * NTHR) z1[i] = (v4u){0u, 0u, 0u, 0u};
                v4u* z2 = (v4u*)(wb + WL_UQ + (size_t)NUQ * CQR * 2); const int n2 = (NUQP - NUQ) * CQR * 2 / 16;
                for (int i = bx * NTHR + tid; i < n2; i += G * NTHR) z2[i] = (v4u){0u, 0u, 0u, 0u};
            }
            if (l == 0) { f32x2* tab = (f32x2*)(ws + WS_TAB);
              for (int i = bx * NTHR + tid; i < TAB_N; i += G * NTHR) {
                  float pos, inv;
                  if (i < TAB_COL) { pos = (float)(i / 32); inv = inv_freq(10000.f, 2 * (i % 32), 64); }
                  else if (i < TAB_PART) { const int q = i - TAB_COL; pos = (float)(q / 32); inv = inv_freq(10000.f, 2 * (q % 32), 64); }
                  else if (i < TAB_MLA) { const int q = i - TAB_PART; pos = (float)(q / 16); inv = inv_freq(500000.f, 2 * (q % 16), 32); }
                  else { const int q = i - TAB_MLA; pos = (float)(q / 32); inv = inv_freq(10000.f, 2 * (q % 32), 64); }
                  const float ang = pos * inv; tab[i] = (f32x2){cosf(ang), sinf(ang)}; } }
            if (l == 0) for (int m = gw; m < T; m += NGW) rms_row_bf16(AP(0) + (size_t)m * DM, AP(1), XN + (size_t)m * DM, lane);
        } else if (k == 0 && PH_EN(0)) {
            pg8::Gemm g{XN, (const pg8::bf16_t*)(wl + WL_IN), T, NINP, DM, DM}; pg8::StaticOrder S; S.init(T, NINP, G, bx);
            pg8::EpiBf16G<0> E{PROJ, NINP, NINP, nullptr, 0};
            pg8::gemm_phase<pg8::EpiBf16G<0>, pg8::StaticOrder, true, true>((LAS unsigned char*)lds, g, S, E);
            if (bx >= G / 2) {
                const int sub_w = (bx - G / 2) * NWAVES + wave, sub_n = (G - G / 2) * NWAVES;
                convert_out(AP(10) + (size_t)l * DM * DM, wl, sub_w, sub_n, lane);
                if (l == 0) convert_ffn(AP(12), AP(15), wl, sub_w, sub_n, lane);
            }
        } else if (k == 1 && PH_EN(1)) {
            for (int m = gw; m < T; m += NGW) prep_row(PROJ + (size_t)m * NINP, KC + (size_t)m * NUQ, m % SEQ, AP(3) + l * 128, AP(4) + l * 128, AP(5) + l * CQR, AP(6) + l * CQR, (const f32x2*)(ws + WS_TAB), lane);
        } else if (k == 2 && PH_EN(2)) {
            { pg8::Gemm g{PROJ + CQ_OFF, (const pg8::bf16_t*)(wl + WL_UQ), T, NUQP, CQR, NINP}; pg8::StaticOrder S; S.init(T, NUQP, G, bx);
              pg8::EpiBf16G<0> E{QC, NUQ, NUQ, nullptr, 0};
              pg8::gemm_phase<pg8::EpiBf16G<0>, pg8::StaticOrder, true, true>((LAS unsigned char*)lds, g, S, E); }
            { pg8::Gemm g{PROJ + CKV_OFF, (const pg8::bf16_t*)(wl + WL_UKV), T, NUKV, CQR, NINP}; pg8::StaticOrder S; S.init(T, NUKV, G, bx);
              pg8::EpiBf16G<1> E{KC, NUQ, 0, VC, 768};
              pg8::gemm_phase<pg8::EpiBf16G<1>, pg8::StaticOrder, true, true>((LAS unsigned char*)lds, g, S, E); }
        } else if (k == 3 && PH_EN(3)) {
            for (int i_ = 0; i_ < 4; ++i_) {
                int u;
                if (G == 256) {
                    if (bx < 64) { if (i_ >= 2) break; u = 192 + 64 * i_ + bx; }
                    else if (bx < 128) { if (i_ >= 2) break; u = (i_ == 0) ? (bx - 64) : (192 + 128 + (bx - 64)); }
                    else { u = (i_ == 0) ? (64 + (bx - 128)) : (384 + (bx - 128) * 3 + (i_ - 1)); }
                } else { u = bx + i_ * G; if (u >= 768) break; }
                if (u < 192) { if (ATT_EN(0)) { const int b = u / 48, h = (u % 48) / 8, qb = u % 8; const size_t r0 = (size_t)b * SEQ;
                    ATTN192(QC + (r0 + qb * 256) * NUQ + h * 192, KC + r0 * NUQ + h * 192, VC + r0 * 768 + h * 128,
                                              Y + (r0 + qb * 256) * DM + 1280 + h * 128, 0.07216878364870322f, (char*)lds, a.ph_hi > 0 ? SEQ : 0, (const float*)(ws + WS_TAB) + (size_t)2 * (TAB_MLA + qb * 256 * 32));
                } } else if (u < 384) { if (ATT_EN(1)) { const int v = u - 192, b = v / 48, h = (v % 48) / 8, qb = v % 8, kvh = h / 3; const size_t r0 = (size_t)b * SEQ;
                    ATTN128(PROJ + (r0 + qb * 256) * NINP + AQ_OFF + h * 128, PROJ + r0 * NINP + AK_OFF + kvh * 128, PROJ + r0 * NINP + AV_OFF + kvh * 128,
                                              Y + (r0 + qb * 256) * DM + h * 128, 0.088388347648318440f, (char*)lds, a.ph_hi > 0 ? SEQ : 0, nullptr);
                } } else { if (ATT_EN(2)) { const int wu = (u - 384) * 8 + wave;
                    const int g = wu / 1024, rem = wu % 1024, b = rem / 256, h = (rem % 256) / 64, blk = rem % 64;
                    const int dil = (g == 0) ? 1 : (g == 1) ? 4 : 16, L = SEQ / dil, nqb = L / 32, res = blk / nqb, qb = blk % nqb;
                    const size_t row0 = (size_t)b * SEQ + res;
                    att::banded_wave_unit(PROJ + row0 * NINP + BQ_OFF + (g * 4 + h) * 128, (long)dil * NINP, PROJ + row0 * NINP + BK_OFF + h * 128, (long)dil * NINP,
                                          PROJ + row0 * NINP + BV_OFF + h * 128, (long)dil * NINP, qb * 32, L,
                                          OB + ((size_t)g * T + row0) * 512 + h * 128, (long)dil * 512, LSE + ((size_t)g * T + row0) * 4 + h, (long)dil * 4, (char*)lds + wave * 8448);
                } }
            }
        } else if (k == 4 && PH_EN(4)) {
            for (int m = gw; m < T; m += NGW) outnorm_row(Y + (size_t)m * DM, OB, LSE, m, AP(9) + l * DM, YN + (size_t)m * DM, lane);
        } else if (k == 5 && PH_EN(5)) {
            pg8::Gemm g{YN, (const pg8::bf16_t*)(wl + WL_OUT), T, DM, DM, DM}; pg8::StaticOrder S; S.init(T, DM, G, bx);
            if (l == 0) { pg8::EpiRes<true> E{AP(0), X, DM}; pg8::gemm_phase<pg8::EpiRes<true>, pg8::StaticOrder, true, true>((LAS unsigned char*)lds, g, S, E); }
            else { pg8::EpiRes<false> E{X2, X, DM}; pg8::gemm_phase<pg8::EpiRes<false>, pg8::StaticOrder, true, true>((LAS unsigned char*)lds, g, S, E); }
        } else if (k == 6 && PH_EN(6)) {
            for (int m = gw; m < T; m += NGW) rmsb_row(X + (size_t)m * DM, AP(11) + l * DM, XN + (size_t)m * DM, nullptr, lane);
        } else if (k == 7 && PH_EN(7)) {
            pg8::Gemm g{XN, (const pg8::bf16_t*)(wl + WL_UP), T, NUP, DM, DM}; pg8::StaticOrder S; S.init(T, NUP, G, bx);
            pg8::EpiConvAct E{ACT, (float*)(ws + WS_HB), AP(13) + (size_t)l * 3 * NUP, AP(14) + (size_t)l * NUP, DFF, NUP};
            pg8::gemm_phase<pg8::EpiConvAct, pg8::StaticOrder, true, true>((LAS unsigned char*)lds, g, S, E);
            if (bx >= G / 2 && l + 1 < DEPTH) {
                convert_ffn(AP(12) + (size_t)(l + 1) * DM * NUP, AP(15) + (size_t)(l + 1) * DFF * DM, wl + WL_SIZE, (bx - G / 2) * NWAVES + wave, (G - G / 2) * NWAVES, lane);
            }
        } else if (k == 8 && PH_EN(8)) {
            { const float* HBp = (const float*)(ws + WS_HB); const float* cw = AP(13) + (size_t)l * 3 * NUP; const float* cb = AP(14) + (size_t)l * NUP;
              for (int it = bx * NTHR + tid; it < (T / 256) * 2 * (DFF / 8); it += G * NTHR) { const int pm = it / (2 * (DFF / 8)), r2 = it % (2 * (DFF / 8)), bot = r2 / (DFF / 8), c = (r2 % (DFF / 8)) * 8;
                      if ((bot == 0 && (pm % 8) == 0) || (bot == 1 && (pm % 8) == 7)) continue;
                      const int pc = 256 * (c / 128) + (c % 128);
                      const float* rp = bot ? HBp + ((size_t)pm * 4 + 2) * NUP : HBp + ((size_t)(pm - 1) * 4 + 3) * NUP;
                      const float* rc = bot ? HBp + ((size_t)pm * 4 + 3) * NUP : HBp + ((size_t)pm * 4 + 0) * NUP;
                      const float* rn = bot ? HBp + ((size_t)(pm + 1) * 4 + 0) * NUP : HBp + ((size_t)pm * 4 + 1) * NUP;
                      float o[8];
#pragma unroll
                      for (int hq = 0; hq < 2; ++hq) {
                          const f32x4 pg = *(const f32x4*)(rp + pc + 4 * hq), cg = *(const f32x4*)(rc + pc + 4 * hq), ng = *(const f32x4*)(rn + pc + 4 * hq);
                          const f32x4 pu = *(const f32x4*)(rp + pc + 128 + 4 * hq), cu = *(const f32x4*)(rc + pc + 128 + 4 * hq), nu = *(const f32x4*)(rn + pc + 128 + 4 * hq);
                          const f32x4 g0 = *(const f32x4*)(cw + c + 4 * hq), g1 = *(const f32x4*)(cw + NUP + c + 4 * hq), g2 = *(const f32x4*)(cw + 2 * NUP + c + 4 * hq), gb = *(const f32x4*)(cb + c + 4 * hq);
                          const f32x4 u0 = *(const f32x4*)(cw + DFF + c + 4 * hq), u1 = *(const f32x4*)(cw + NUP + DFF + c + 4 * hq), u2 = *(const f32x4*)(cw + 2 * NUP + DFF + c + 4 * hq), ub = *(const f32x4*)(cb + DFF + c + 4 * hq);
#pragma unroll
                          for (int j = 0; j < 4; ++j) { const float gg = gb[j] + g0[j] * pg[j] + g1[j] * cg[j] + g2[j] * ng[j], uv = ub[j] + u0[j] * pu[j] + u1[j] * cu[j] + u2[j] * nu[j];
                              o[4 * hq + j] = gg * __builtin_amdgcn_rcpf(1.f + __builtin_amdgcn_exp2f(-1.4426950408889634f * gg)) * uv; } }
                      v4u w; w.x = pk2(o[0], o[1]); w.y = pk2(o[2], o[3]); w.z = pk2(o[4], o[5]); w.w = pk2(o[6], o[7]);
                      *(v4u*)(ACT + (size_t)(pm * 256 + (bot ? 255 : 0)) * DFF + c) = w; } }
        } else if (k == 9 && PH_EN(9)) {
            pg8::Gemm g{ACT, (const pg8::bf16_t*)(wl + WL_DN), T, DM, DFF, DFF}; pg8::StaticOrder S; S.init(T, DM, G, bx);
            pg8::EpiRes<false> E{X, X2, DM}; pg8::gemm_phase<pg8::EpiRes<false>, pg8::StaticOrder, true, true>((LAS unsigned char*)lds, g, S, E);
        } else {
            if (l + 1 < DEPTH) { for (int m = gw; m < T; m += NGW) rmsb_row(X2 + (size_t)m * DM, AP(1) + (l + 1) * DM, XN + (size_t)m * DM, nullptr, lane); }
            else { for (int m = gw; m < T; m += NGW) rmsb_row(X2 + (size_t)m * DM, AP(16), nullptr, ((float*)AP(17)) + (size_t)m * DM, lane); }
        }
#ifdef EXTRA_SYNCS
        if (ph == 0) for (int e_ = 0; e_ < EXTRA_SYNCS; ++e_) GRID_BAR();
#endif
#ifdef REP_PH
        if (it_ + 1 < a.ph_hi + REP_X) GRID_BAR();
#else
        if (ph + 1 < a.ph_hi) GRID_BAR();
#endif
#ifdef DIAG_A
        if (bx == 0 && threadIdx.x == 0) ((unsigned long long*)ws)[16 + ph + 1] = __builtin_amdgcn_s_memrealtime();
#endif
    }
#ifdef DIAG_A
    grid.sync();
    if (bx == 0) { const unsigned long long* ts = (const unsigned long long*)ws + 16;
        const float dA = (float)(ts[DIAG_A1] - ts[DIAG_A]) * 0.01f, dB = (float)(ts[DIAG_B1] - ts[DIAG_B]) * 0.01f;
        if (threadIdx.x == 0) ((float*)AP(17))[0] += dA;
        for (int i = threadIdx.x; i < 10000; i += NTHR) ((float*)AP(17))[2048 + i] += 0.1f * dB; }
#endif
}
#undef AP
#undef XN
#undef X
#undef X2
#undef PROJ
#undef QC
#undef KC
#undef VC
#undef OB
#undef LSE
#undef H
#undef Y
#undef YN
#undef ACT

#ifndef N_LAUNCH_MODE
#define N_LAUNCH_MODE 1
#endif
extern "C" void kernel_launch(void* const* d_in, const int* in_sizes, int n_in, void* d_out, int out_size, void* d_ws, size_t ws_size, hipStream_t stream) {
    static int grid = 0;
    if (grid == 0) {
        if (n_in != 17 || out_size != T * DM || ws_size < WS_END) { fprintf(stderr, "kernel_launch: unexpected shapes: n_in %d out %d ws %zu (need %zu)\n", n_in, out_size, ws_size, (size_t)WS_END); grid = -1; return; }
        int dev = 0, cus = 0, per_cu = 0;
        if (hipGetDevice(&dev) != hipSuccess || hipDeviceGetAttribute(&cus, hipDeviceAttributeMultiprocessorCount, dev) != hipSuccess) { grid = -1; return; }
        if (hipFuncSetAttribute((const void*)fwd, hipFuncAttributeMaxDynamicSharedMemorySize, LDS_BYTES) != hipSuccess) { fprintf(stderr, "kernel_launch: hipFuncSetAttribute failed\n"); grid = -1; return; }
        if (hipOccupancyMaxActiveBlocksPerMultiprocessor(&per_cu, (const void*)fwd, NTHR, LDS_BYTES) != hipSuccess || per_cu < 1) { fprintf(stderr, "kernel_launch: occupancy query says %d\n", per_cu); (void)hipGetLastError(); }
        grid = cus;
        fprintf(stderr, "kernel_launch: grid %d per_cu %d ws %zu need %zu\n", grid, per_cu, ws_size, (size_t)WS_END);
    }
    if (grid < 0) return;
    if (hipMemsetAsync(d_ws, 0, CTL_ZERO_BYTES, stream) != hipSuccess) { fprintf(stderr, "kernel_launch: memset failed\n"); return; }
    Args a{};
    a.x = (const float*)d_in[0]; a.attn_norm = (const float*)d_in[1]; a.w_in = (const float*)d_in[2]; a.a_q_norm = (const float*)d_in[3]; a.a_k_norm = (const float*)d_in[4];
    a.c_q_norm = (const float*)d_in[5]; a.c_kv_norm = (const float*)d_in[6]; a.w_uq = (const float*)d_in[7]; a.w_ukv = (const float*)d_in[8]; a.out_norm = (const float*)d_in[9];
    a.w_out = (const float*)d_in[10]; a.ffn_norm = (const float*)d_in[11]; a.w_up = (const float*)d_in[12]; a.conv_w = (const float*)d_in[13]; a.conv_b = (const float*)d_in[14];
    a.w_down = (const float*)d_in[15]; a.final_norm = (const float*)d_in[16];
    a.out = (float*)d_out; a.ws = (unsigned char*)d_ws;
#if N_LAUNCH_MODE == 1
    a.ph_lo = 0; a.ph_hi = NPH;
    { void* args[] = {&a}; hipError_t e = hipLaunchCooperativeKernel((void*)fwd, dim3(grid), dim3(NTHR), args, LDS_BYTES, stream);
      if (e != hipSuccess) fprintf(stderr, "kernel_launch: cooperative launch failed: %s\n", hipGetErrorString(e)); }
#else
    for (int ph = 0; ph < NPH; ++ph) { a.ph_lo = ph; a.ph_hi = ph + 1; void* args[] = {&a};
        hipError_t e = hipLaunchCooperativeKernel((void*)fwd, dim3(grid), dim3(NTHR), args, LDS_BYTES, stream);
        if (e != hipSuccess) { fprintf(stderr, "kernel_launch: launch %d failed: %s\n", ph, hipGetErrorString(e)); break; } }
#endif
}
```

```cpp
#include <hip/hip_runtime.h>
#include <hip/hip_cooperative_groups.h>
#include <hip/hip_bf16.h>
#include <cstdio>
#include <cstdint>
#include <cmath>
namespace cg = cooperative_groups;
namespace pg8 {
#define PG8_LAS __attribute__((address_space(3)))
typedef unsigned short bf16_t;
typedef short bf16x8 __attribute__((ext_vector_type(8)));
typedef float f32x4 __attribute__((ext_vector_type(4)));
typedef unsigned u32x4 __attribute__((ext_vector_type(4)));
constexpr int BM = 256, BK = 64, HALF = 128, HTB = HALF * BK * 2  , STAGE_BYTES = 8 * HTB, NXCD = 8, WGM = 4;

__host__ __device__ __forceinline__ int lds_byte(int r, int c) { const int st = (r >> 4) * 2 + (c >> 5), rr = r & 15, cc = c & 31, ob = rr * 64 + cc * 2; return st * 1024 + (ob ^ (((ob >> 9) & 1) << 5)); }
__host__ __device__ __forceinline__ void stage_rc(int b, int& R, int& C) { const int st = b / 1024, sb = b % 1024, swz = sb ^ (((sb >> 9) & 1) << 5); R = (st >> 1) * 16 + swz / 64; C = (st & 1) * 32 + (swz % 64) / 2; }
__host__ __device__ __forceinline__ int perm32(int rho) { const int n = rho >> 4, i = rho & 15; return 8 * (i >> 2) + 4 * n + (i & 3); }

struct Unit { int pm, pn; };
struct Gemm { const bf16_t* A; const bf16_t* Bt; int M, N, K, lda; };

struct StaticOrder {
    int nM, nN, nwg, G, c;
    __host__ __device__ void init(int M, int N, int G_, int c_) { nM = M / BM; nN = N / BM; nwg = nM * nN; G = G_; c = c_; }
    __host__ __device__ bool next(int i, Unit& u) const {
        const long L = (long)i * G + c; if (L >= nwg) return false;
        int wgid = (int)L; { const int q = nwg / NXCD, r = nwg % NXCD, xcd = wgid % NXCD, off = wgid / NXCD; wgid = (xcd < r ? xcd * (q + 1) : r * (q + 1) + (xcd - r) * q) + off; }
        const int nig = WGM * nN, gid = wgid / nig, fm = gid * WGM, gsz = (nM - fm) < WGM ? (nM - fm) : WGM;
        u.pm = fm + ((wgid % nig) % gsz); u.pn = (wgid % nig) / gsz; return true;
    }
    __device__ __forceinline__ void a_ready(const Unit&) const {}
    __device__ __forceinline__ void done(const Unit&) const {}
};

__device__ __forceinline__ unsigned cvt_pk_bf16(float lo, float hi) { unsigned r; asm volatile("v_cvt_pk_bf16_f32 %0, %1, %2" : "=v"(r) : "v"(lo), "v"(hi)); return r; }

template <int MODE> struct EpiBf16G {
    static constexpr bool PERM = true, AFTER_DRAIN = false, USES_LDS = false;
    bf16_t* O; int ldc; int ncols; bf16_t* O2; int ldc2;
    __device__ __forceinline__ void operator()(const f32x4 (&acc)[2][2][4][2], const Unit& u, int wr, int wc, int fr, int fq) const {
        const int row0 = u.pm * BM + wr * 64 + fr;
#pragma unroll
        for (int ai = 0; ai < 2; ++ai)
#pragma unroll
            for (int m = 0; m < 4; ++m) { const size_t row = (size_t)(row0 + ai * HALF + m * 16);
#pragma unroll
                for (int bj = 0; bj < 2; ++bj) {
                    const f32x4 v0 = acc[ai][bj][m][0], v1 = acc[ai][bj][m][1];
                    u32x4 w; w.x = cvt_pk_bf16(v0[0], v0[1]); w.y = cvt_pk_bf16(v0[2], v0[3]); w.z = cvt_pk_bf16(v1[0], v1[1]); w.w = cvt_pk_bf16(v1[2], v1[3]);
                    if (MODE == 0) { const int col = u.pn * BM + bj * HALF + wc * 32 + 8 * fq; if (col < ncols) *(u32x4*)(O + row * ldc + col) = w; }
                    else { if (bj == 0) *(u32x4*)(O + row * ldc + u.pn * 192 + wc * 32 + 8 * fq) = w; else *(u32x4*)(O2 + row * ldc2 + u.pn * 128 + wc * 32 + 8 * fq) = w; }
                } }
    }
};

__device__ __forceinline__ void scale_rows_by_rstd8(f32x4 (&acc)[2][2][4][2], const float* SS, const Unit& u, int wr, int fr, PG8_LAS unsigned char* xl, float inv_width, float eps) {
    PG8_LAS float* RS = (PG8_LAS float*)(xl + 8192);
    int tid = threadIdx.x; asm volatile("" : "+v"(tid));
    if (tid < 256) { const f32x4* p = (const f32x4*)(SS + (size_t)(u.pm * BM + tid) * 8); const f32x4 s = p[0] + p[1];
        RS[tid] = 1.f / sqrtf(((s[0] + s[1]) + (s[2] + s[3])) * inv_width + eps); }
    asm volatile("s_waitcnt lgkmcnt(0)" ::: "memory"); __builtin_amdgcn_s_barrier(); asm volatile("" ::: "memory");
#pragma unroll
    for (int ai = 0; ai < 2; ++ai)
#pragma unroll
        for (int m = 0; m < 4; ++m) { const float r = RS[ai * HALF + wr * 64 + m * 16 + fr];
#pragma unroll
            for (int bj = 0; bj < 2; ++bj)
#pragma unroll
                for (int n = 0; n < 2; ++n) acc[ai][bj][m][n] *= r; }
}
template <int MODE> struct EpiBf16Rs {
    static constexpr bool PERM = true, AFTER_DRAIN = false, USES_LDS = true;
    bf16_t* O; int ldc; int ncols; bf16_t* O2; int ldc2; const float* SS; float inv_width, eps;
    __device__ __forceinline__ void run(f32x4 (&acc)[2][2][4][2], const Unit& u, int wr, int wc, int fr_, int fq_, PG8_LAS unsigned char* xl, int wid, int lane) const {
        int fr = fr_, fq = fq_; asm volatile("" : "+v"(fr), "+v"(fq));
        scale_rows_by_rstd8(acc, SS, u, wr, fr, xl, inv_width, eps);
        const int row0 = u.pm * BM + wr * 64 + fr;
#pragma unroll
        for (int ai = 0; ai < 2; ++ai)
#pragma unroll
            for (int m = 0; m < 4; ++m) { const size_t row = (size_t)(row0 + ai * HALF + m * 16);
#pragma unroll
                for (int bj = 0; bj < 2; ++bj) {
                    const f32x4 v0 = acc[ai][bj][m][0], v1 = acc[ai][bj][m][1];
                    u32x4 w; w.x = cvt_pk_bf16(v0[0], v0[1]); w.y = cvt_pk_bf16(v0[2], v0[3]); w.z = cvt_pk_bf16(v1[0], v1[1]); w.w = cvt_pk_bf16(v1[2], v1[3]);
                    if (MODE == 0) { const int col = u.pn * BM + bj * HALF + wc * 32 + 8 * fq; if (col < ncols) *(u32x4*)(O + row * ldc + col) = w; }
                    else { if (bj == 0) *(u32x4*)(O + row * ldc + u.pn * 192 + wc * 32 + 8 * fq) = w; else *(u32x4*)(O2 + row * ldc2 + u.pn * 128 + wc * 32 + 8 * fq) = w; }
                } }
    }
};
struct EpiBf16Lat {
    static constexpr bool PERM = true, AFTER_DRAIN = false, USES_LDS = false;
    bf16_t* O; int ldc; float* SS; int lat0; int M;
    __device__ __forceinline__ void operator()(const f32x4 (&acc)[2][2][4][2], const Unit& u, int wr, int wc, int fr_, int fq_) const {
        int fr = fr_, fq = fq_; asm volatile("" : "+v"(fr), "+v"(fq));
        const int row0 = u.pm * BM + wr * 64 + fr; const bool lat = (u.pn >= lat0) && (u.pn < lat0 + 4);
        float* ssp = SS + ((size_t)((u.pn - lat0) >> 1) * M) * 8 + ((u.pn - lat0) & 1) * 4 + wc;
#pragma unroll
        for (int ai = 0; ai < 2; ++ai)
#pragma unroll
            for (int m = 0; m < 4; ++m) { const size_t row = (size_t)(row0 + ai * HALF + m * 16); float s = 0.f;
#pragma unroll
                for (int bj = 0; bj < 2; ++bj) {
                    const f32x4 v0 = acc[ai][bj][m][0], v1 = acc[ai][bj][m][1];
                    u32x4 w; w.x = cvt_pk_bf16(v0[0], v0[1]); w.y = cvt_pk_bf16(v0[2], v0[3]); w.z = cvt_pk_bf16(v1[0], v1[1]); w.w = cvt_pk_bf16(v1[2], v1[3]);
                    *(u32x4*)(O + row * ldc + u.pn * BM + bj * HALF + wc * 32 + 8 * fq) = w;
                    s += ((v0[0] * v0[0] + v0[1] * v0[1]) + (v0[2] * v0[2] + v0[3] * v0[3])) + ((v1[0] * v1[0] + v1[1] * v1[1]) + (v1[2] * v1[2] + v1[3] * v1[3])); }
                if (lat) { s += __shfl_xor(s, 16); s += __shfl_xor(s, 32); if (fq == 0) ssp[row * 8] = s; } }
    }
};
template <bool BASE_F32> struct EpiRes {
    static constexpr bool PERM = false, AFTER_DRAIN = false, USES_LDS = false;
    const void* base; bf16_t* out; int ldc;
    __device__ __forceinline__ void operator()(const f32x4 (&acc)[2][2][4][2], const Unit& u, int wr, int wc, int fr, int fq) const {
        typedef unsigned u32x2v __attribute__((ext_vector_type(2)));
        const int row0 = u.pm * BM + wr * 64 + fr, col0 = u.pn * BM + wc * 32 + 4 * fq;
#pragma unroll
        for (int ai = 0; ai < 2; ++ai)
#pragma unroll
            for (int m = 0; m < 4; ++m) { const size_t off = (size_t)(row0 + ai * HALF + m * 16) * ldc + col0;
#pragma unroll
                for (int bj = 0; bj < 2; ++bj)
#pragma unroll
                    for (int n = 0; n < 2; ++n) { f32x4 b;
                        if (BASE_F32) b = *(const f32x4*)((const float*)base + off + bj * HALF + n * 16);
                        else { const u32x2v r = *(const u32x2v*)((const bf16_t*)base + off + bj * HALF + n * 16);
                               b = (f32x4){__builtin_bit_cast(float, r.x << 16), __builtin_bit_cast(float, r.x & 0xffff0000u), __builtin_bit_cast(float, r.y << 16), __builtin_bit_cast(float, r.y & 0xffff0000u)}; }
                        const f32x4 v = b + acc[ai][bj][m][n]; u32x2v w; w.x = cvt_pk_bf16(v[0], v[1]); w.y = cvt_pk_bf16(v[2], v[3]);
                        *(u32x2v*)(out + off + bj * HALF + n * 16) = w; } }
    }
};
template <bool BASE_F32> struct EpiResNorm {
    static constexpr bool PERM = false, AFTER_DRAIN = true, USES_LDS = false;
    const void* base; bf16_t* xout; const float* gain; bf16_t* nbf; float* nf32; int ldc; float* xbuf; unsigned* cnt; float inv_width, eps;
    __device__ __forceinline__ void fused(f32x4 (&acc)[2][2][4][2], const Unit& u, int wr, int wc, int fr_, int fq_, PG8_LAS unsigned char* lds, int wid, int lane_) const {
        typedef unsigned u32x2v __attribute__((ext_vector_type(2)));
        int fr = fr_, fq = fq_, lane = lane_; asm volatile("" : "+v"(fr), "+v"(fq), "+v"(lane));
        PG8_LAS float* P = (PG8_LAS float*)lds;
        PG8_LAS float* S = (PG8_LAS float*)(lds + 4096);
        const int tid = wid * 64 + lane;
        const int row0 = u.pm * BM + wr * 64 + fr, col0 = u.pn * BM + wc * 32 + 4 * fq;
#pragma unroll
        for (int ai = 0; ai < 2; ++ai) {
            if constexpr (BASE_F32) {
#pragma unroll
                for (int mp = 0; mp < 2; ++mp) { f32x4 b[2][2][2];
#pragma unroll
                    for (int mm = 0; mm < 2; ++mm)
#pragma unroll
                        for (int bj = 0; bj < 2; ++bj)
#pragma unroll
                            for (int n = 0; n < 2; ++n) b[mm][bj][n] = *(const f32x4*)((const float*)base + (size_t)(row0 + ai * HALF + (2 * mp + mm) * 16) * ldc + col0 + bj * HALF + n * 16);
                    __builtin_amdgcn_sched_barrier(0);
#pragma unroll
                    for (int mm = 0; mm < 2; ++mm)
#pragma unroll
                        for (int bj = 0; bj < 2; ++bj)
#pragma unroll
                            for (int n = 0; n < 2; ++n) { acc[ai][bj][2 * mp + mm][n] += b[mm][bj][n]; asm volatile("" : "+v"(acc[ai][bj][2 * mp + mm][n])); }
                    __builtin_amdgcn_sched_barrier(0); }
            } else { u32x2v r[4][2][2];
#pragma unroll
                for (int m = 0; m < 4; ++m)
#pragma unroll
                    for (int bj = 0; bj < 2; ++bj)
#pragma unroll
                        for (int n = 0; n < 2; ++n) r[m][bj][n] = *(const u32x2v*)((const bf16_t*)base + (size_t)(row0 + ai * HALF + m * 16) * ldc + col0 + bj * HALF + n * 16);
                __builtin_amdgcn_sched_barrier(0);
#pragma unroll
                for (int m = 0; m < 4; ++m)
#pragma unroll
                    for (int bj = 0; bj < 2; ++bj)
#pragma unroll
                        for (int n = 0; n < 2; ++n) { const u32x2v q = r[m][bj][n];
                            acc[ai][bj][m][n] += (f32x4){__builtin_bit_cast(float, q.x << 16), __builtin_bit_cast(float, q.x & 0xffff0000u), __builtin_bit_cast(float, q.y << 16), __builtin_bit_cast(float, q.y & 0xffff0000u)};
                            asm volatile("" : "+v"(acc[ai][bj][m][n])); }
                __builtin_amdgcn_sched_barrier(0); }
        }
#pragma unroll
        for (int ai = 0; ai < 2; ++ai)
#pragma unroll
            for (int m = 0; m < 4; ++m) { const size_t off = (size_t)(row0 + ai * HALF + m * 16) * ldc + col0; float s = 0.f;
#pragma unroll
                for (int bj = 0; bj < 2; ++bj)
#pragma unroll
                    for (int n = 0; n < 2; ++n) { const f32x4 v = acc[ai][bj][m][n];
                        if (xout) { u32x2v w; w.x = cvt_pk_bf16(v[0], v[1]); w.y = cvt_pk_bf16(v[2], v[3]); *(u32x2v*)(xout + off + bj * HALF + n * 16) = w; }
                        s += (v[0] * v[0] + v[1] * v[1]) + (v[2] * v[2] + v[3] * v[3]); }
                s += __shfl_xor(s, 16); s += __shfl_xor(s, 32);
                if (fq == 0) P[(ai * HALF + wr * 64 + m * 16 + fr) * 4 + wc] = s; }
        f32x4 gv[2][2];
#pragma unroll
        for (int bj = 0; bj < 2; ++bj)
#pragma unroll
            for (int n = 0; n < 2; ++n) gv[bj][n] = *(const f32x4*)(gain + col0 + bj * HALF + n * 16);
        asm volatile("s_waitcnt lgkmcnt(0)" ::: "memory"); __builtin_amdgcn_s_barrier(); asm volatile("" ::: "memory");
        if (tid < 256) { const f32x4 p = *(PG8_LAS f32x4*)(P + tid * 4); const float s = (p[0] + p[1]) + (p[2] + p[3]);
            __hip_atomic_store(xbuf + ((size_t)(u.pm * 8 + u.pn) * BM + tid), s, __ATOMIC_RELAXED, __HIP_MEMORY_SCOPE_AGENT); }
        asm volatile("s_waitcnt vmcnt(0)" ::: "memory");
        if (tid < 256 && lane == 0) __hip_atomic_fetch_add(cnt + 64 * u.pm, 1u, __ATOMIC_RELAXED, __HIP_MEMORY_SCOPE_AGENT);
        if (wid == 0) { unsigned sp = 0;
            while ((unsigned)__builtin_amdgcn_readfirstlane(__hip_atomic_load(cnt + 64 * u.pm, __ATOMIC_RELAXED, __HIP_MEMORY_SCOPE_AGENT)) < 32u) { __builtin_amdgcn_s_sleep(2); if (++sp > (1u << 20)) break; }
            __builtin_amdgcn_fence(__ATOMIC_ACQUIRE, "agent"); }
        asm volatile("s_waitcnt vmcnt(0) lgkmcnt(0)" ::: "memory"); __builtin_amdgcn_s_barrier(); asm volatile("" ::: "memory");
        if (tid < 256) { const float* slot = xbuf + ((size_t)u.pm * 8 * BM + tid); float t8[8];
#pragma unroll
            for (int t = 0; t < 8; ++t) t8[t] = __hip_atomic_load(slot + t * BM, __ATOMIC_RELAXED, __HIP_MEMORY_SCOPE_AGENT);
            __builtin_amdgcn_sched_barrier(0);
            const float s = ((t8[0] + t8[1]) + (t8[2] + t8[3])) + ((t8[4] + t8[5]) + (t8[6] + t8[7]));
            S[tid] = 1.f / sqrtf(s * inv_width + eps); }
        asm volatile("s_waitcnt lgkmcnt(0)" ::: "memory"); __builtin_amdgcn_s_barrier(); asm volatile("" ::: "memory");
#pragma unroll
        for (int ai = 0; ai < 2; ++ai)
#pragma unroll
            for (int m = 0; m < 4; ++m) { const float r = S[ai * HALF + wr * 64 + m * 16 + fr]; const size_t off = (size_t)(row0 + ai * HALF + m * 16) * ldc + col0;
#pragma unroll
                for (int bj = 0; bj < 2; ++bj)
#pragma unroll
                    for (int n = 0; n < 2; ++n) { const f32x4 gg = gv[bj][n]; const f32x4 o = acc[ai][bj][m][n] * r * gg;
                        if (nbf) { u32x2v w; w.x = cvt_pk_bf16(o[0], o[1]); w.y = cvt_pk_bf16(o[2], o[3]); *(u32x2v*)(nbf + off + bj * HALF + n * 16) = w; }
                        if (nf32) __builtin_nontemporal_store(o, (f32x4*)(nf32 + off + bj * HALF + n * 16)); } }
    }
};
__device__ __forceinline__ float dpp_prev(float x, float xm) {
    const int e = __builtin_amdgcn_mov_dpp(__builtin_bit_cast(int, xm), 0x121, 0xf, 0xf, false);
    return __builtin_bit_cast(float, __builtin_amdgcn_update_dpp(e, __builtin_bit_cast(int, x), 0x111, 0xf, 0xf, false)); }
__device__ __forceinline__ float dpp_next(float x, float xp) {
    const int e = __builtin_amdgcn_mov_dpp(__builtin_bit_cast(int, xp), 0x12f, 0xf, 0xf, false);
    return __builtin_bit_cast(float, __builtin_amdgcn_update_dpp(e, __builtin_bit_cast(int, x), 0x101, 0xf, 0xf, false)); }
struct EpiConvAct {
    static constexpr bool PERM = true, AFTER_DRAIN = false, USES_LDS = true;
    bf16_t* ACT; float* HB; const float* cw; const float* cb; int dff, nup;
    __device__ __forceinline__ void run(const f32x4 (&acc)[2][2][4][2], const Unit& u, int wr, int wc, int fr_, int fq_, PG8_LAS unsigned char* xl, int wid, int lane) const {
        int fr = fr_, fq = fq_; asm volatile("" : "+v"(fr), "+v"(fq));
        PG8_LAS float* X = (PG8_LAS float*)xl;
        PG8_LAS float* Wl = X + 2048;
        f32x4 wst = (f32x4){0.f, 0.f, 0.f, 0.f};
        if (wr == 0) { const int t = (wid & 3) * 64 + lane, k = t >> 6, pc = (t & 63) * 4;
            wst = *(const f32x4*)((k < 3 ? cw + (size_t)k * nup : cb) + (pc >> 7) * dff + u.pn * HALF + (pc & 127)); }
#pragma unroll
        for (int ai = 0; ai < 2; ++ai)
#pragma unroll
            for (int bj = 0; bj < 2; ++bj)
#pragma unroll
                for (int n = 0; n < 2; ++n) {
                    if (fr == 0)  *(PG8_LAS f32x4*)(X + ((((wid * 2 + ai) * 2 + 0) * 2 + bj) * 2 + n) * 16 + fq * 4) = acc[ai][bj][0][n];
                    if (fr == 15) *(PG8_LAS f32x4*)(X + ((((wid * 2 + ai) * 2 + 1) * 2 + bj) * 2 + n) * 16 + fq * 4) = acc[ai][bj][3][n];
                }
        if (wr == 0 && fr < 2) { float* hb = HB + ((size_t)u.pm * 4 + fr) * nup + u.pn * BM + wc * 32 + 8 * fq;
#pragma unroll
            for (int bj = 0; bj < 2; ++bj)
#pragma unroll
                for (int n = 0; n < 2; ++n) *(f32x4*)(hb + bj * HALF + 4 * n) = acc[0][bj][0][n]; }
        if (wr == 1 && fr >= 14) { float* hb = HB + ((size_t)u.pm * 4 + 2 + (fr - 14)) * nup + u.pn * BM + wc * 32 + 8 * fq;
#pragma unroll
            for (int bj = 0; bj < 2; ++bj)
#pragma unroll
                for (int n = 0; n < 2; ++n) *(f32x4*)(hb + bj * HALF + 4 * n) = acc[1][bj][3][n]; }
        if (wr == 0) *(PG8_LAS f32x4*)(Wl + ((wid & 3) * 64 + lane) * 4) = wst;
        asm volatile("s_waitcnt lgkmcnt(0)" ::: "memory"); __builtin_amdgcn_s_barrier(); asm volatile("" ::: "memory");
        const int ch0 = u.pn * HALF + wc * 32 + 8 * fq;
        const int pw = wid ^ 4;
#pragma unroll
        for (int ai = 0; ai < 2; ++ai) {
            unsigned pk[4][2][2];
#pragma unroll
            for (int n = 0; n < 2; ++n) {
                f32x4 wg[3], wu[3];
                const PG8_LAS float* wl = Wl + wc * 32 + 8 * fq + 4 * n;
#pragma unroll
                for (int k = 0; k < 3; ++k) { wg[k] = *(const PG8_LAS f32x4*)(wl + k * 256); wu[k] = *(const PG8_LAS f32x4*)(wl + k * 256 + 128); }
                const f32x4 bg = *(const PG8_LAS f32x4*)(wl + 768), bu = *(const PG8_LAS f32x4*)(wl + 896);
#pragma unroll
                for (int m = 0; m < 4; ++m) {
                    f32x4 cv[2];
#pragma unroll
                    for (int bj = 0; bj < 2; ++bj) {
                        const f32x4 x = acc[ai][bj][m][n];
                        f32x4 xm, xp; const f32x4 z = (f32x4){0.f, 0.f, 0.f, 0.f};
                        if (m > 0) xm = acc[ai][bj][m > 0 ? m - 1 : 0][n];
                        else if (wr == 1) xm = *(PG8_LAS f32x4*)(X + ((((pw * 2 + ai) * 2 + 1) * 2 + bj) * 2 + n) * 16 + fq * 4);
                        else if (ai == 1) xm = *(PG8_LAS f32x4*)(X + ((((pw * 2 + 0) * 2 + 1) * 2 + bj) * 2 + n) * 16 + fq * 4);
                        else xm = z;
                        if (m < 3) xp = acc[ai][bj][m < 3 ? m + 1 : 3][n];
                        else if (wr == 0) xp = *(PG8_LAS f32x4*)(X + ((((pw * 2 + ai) * 2 + 0) * 2 + bj) * 2 + n) * 16 + fq * 4);
                        else if (ai == 0) xp = *(PG8_LAS f32x4*)(X + ((((pw * 2 + 1) * 2 + 0) * 2 + bj) * 2 + n) * 16 + fq * 4);
                        else xp = z;
                        const f32x4 w0 = bj ? wu[0] : wg[0], w1 = bj ? wu[1] : wg[1], w2 = bj ? wu[2] : wg[2], bb = bj ? bu : bg;
                        f32x4 pv, nx;
#pragma unroll
                        for (int j = 0; j < 4; ++j) { pv[j] = dpp_prev(x[j], xm[j]); nx[j] = dpp_next(x[j], xp[j]); }
                        cv[bj] = bb + w0 * pv + w1 * x + w2 * nx;
                    }
                    f32x4 o; { const f32x4 g = cv[0], t = g * (-1.4426950408889634f); f32x4 d;
#pragma unroll
                      for (int j = 0; j < 4; ++j) d[j] = __builtin_amdgcn_exp2f(t[j]);
                      d = d + 1.f;
#pragma unroll
                      for (int j = 0; j < 4; ++j) d[j] = __builtin_amdgcn_rcpf(d[j]);
                      o = (g * d) * cv[1]; }
                    pk[m][n][0] = cvt_pk_bf16(o[0], o[1]); pk[m][n][1] = cvt_pk_bf16(o[2], o[3]);
                }
            }
#pragma unroll
            for (int m = 0; m < 4; ++m) { u32x4 w; w.x = pk[m][0][0]; w.y = pk[m][0][1]; w.z = pk[m][1][0]; w.w = pk[m][1][1];
                *(u32x4*)(ACT + (size_t)(u.pm * BM + ai * HALF + wr * 64 + m * 16 + fr) * dff + ch0) = w; }
            asm volatile("" ::: "memory");
        }
    }
};
template <class Epi, class Sched, bool ALIGN_EPI = false, bool SP2 = false>
__device__ __forceinline__ void gemm_phase(PG8_LAS unsigned char* lds, const Gemm g, const Sched& S, const Epi& E) {
    int tid_ = threadIdx.x; asm volatile("" : "+v"(tid_));
    const int tid = tid_, wid = __builtin_amdgcn_readfirstlane(tid >> 6), lane = tid & 63, wr = wid >> 2, wc = wid & 3, fr = lane & 15, fq = lane >> 4;
    const int K = g.K, nt = K / BK;
    unsigned voffA[2], voffB[2];
#pragma unroll
    for (int i = 0; i < 2; ++i) { int R, C; stage_rc(tid * 16 + i * 8192, R, C); const int Rb = Epi::PERM ? ((R & ~31) + perm32(R & 31)) : R;
        voffA[i] = (unsigned)(R * g.lda + C) * 2u; voffB[i] = (unsigned)(Rb * K + C) * 2u; }
    const size_t kstep = (size_t)(BK * 2);
    const size_t hstepA = (size_t)HALF * g.lda * 2, hstepB = (size_t)HALF * K * 2;
    const size_t tstepA = 2 * hstepA, tstepB = 2 * hstepB;
    const unsigned ldsw = (unsigned)wid * 1024u;
    const int aoff = lds_byte(wr * 64 + fr, fq * 8), boff = lds_byte(wc * 32 + fr, fq * 8);
#define PG8_SA(b, h) (((b) * 2 + (h)) * HTB)
#define PG8_SB(b, h) ((4 + (b) * 2 + (h)) * HTB)
#define PG8_STAGE(bufoff, gbase, voff) do { _Pragma("unroll") for (int _i = 0; _i < 2; ++_i) \
        __builtin_amdgcn_global_load_lds((const unsigned*)((const char*)(gbase) + (voff)[_i]), (PG8_LAS unsigned*)(lds + (bufoff) + ldsw + _i * 8192), 16, 0, 0); } while (0)
#define PG8_LDA(dst, b, h) do { _Pragma("unroll") for (int m = 0; m < 4; ++m) _Pragma("unroll") for (int k = 0; k < 2; ++k) dst[m][k] = *(const PG8_LAS bf16x8*)(lds + PG8_SA(b, h) + aoff + m * 2048 + k * 1024); } while (0)
#define PG8_LDB(dst, b, h) do { _Pragma("unroll") for (int n = 0; n < 2; ++n) _Pragma("unroll") for (int k = 0; k < 2; ++k) dst[n][k] = *(const PG8_LAS bf16x8*)(lds + PG8_SB(b, h) + boff + n * 2048 + k * 1024); } while (0)
#define PG8_MMA(ai, bj, At, Bt) do { __builtin_amdgcn_s_setprio(1); _Pragma("unroll") for (int m = 0; m < 4; ++m) _Pragma("unroll") for (int n = 0; n < 2; ++n) _Pragma("unroll") for (int k = 0; k < 2; ++k) \
        acc[ai][bj][m][n] = __builtin_amdgcn_mfma_f32_16x16x32_bf16(Bt[n][k], At[m][k], acc[ai][bj][m][n], 0, 0, 0); __builtin_amdgcn_s_setprio(0); } while (0)
#define PG8_WAIT_V(n) asm volatile("s_waitcnt vmcnt(" #n ")" ::: "memory")
#define PG8_WAIT_L(n) asm volatile("s_waitcnt lgkmcnt(" #n ")" ::: "memory")
#define PG8_BAR __builtin_amdgcn_s_barrier()
#define PG8_SCHED __builtin_amdgcn_sched_barrier(0)
    Unit cur, nxt; int ui = 0;
    if (!S.next(0, cur)) return;
    f32x4 acc[2][2][4][2];
#pragma unroll
    for (int a = 0; a < 2; ++a)
#pragma unroll
        for (int b = 0; b < 2; ++b)
#pragma unroll
            for (int m = 0; m < 4; ++m)
#pragma unroll
                for (int n = 0; n < 2; ++n) acc[a][b][m][n] = (f32x4){0.f, 0.f, 0.f, 0.f};
    bf16x8 At[4][2], B0[2][2], B1[2][2];
    const char* cA = (const char*)g.A + (size_t)cur.pm * tstepA; const char* cB = (const char*)g.Bt + (size_t)cur.pn * tstepB;
    S.a_ready(cur);
    if constexpr (SP2) {
        PG8_STAGE(PG8_SB(0, 0), cB, voffB); PG8_STAGE(PG8_SB(0, 1), cB + hstepB, voffB); PG8_STAGE(PG8_SA(0, 0), cA, voffA); PG8_STAGE(PG8_SA(0, 1), cA + hstepA, voffA);
        if (wr == 1) PG8_BAR;
        PG8_WAIT_V(2); PG8_BAR;
        PG8_STAGE(PG8_SB(1, 0), cB + kstep, voffB); PG8_STAGE(PG8_SA(1, 0), cA + kstep, voffA); PG8_STAGE(PG8_SB(1, 1), cB + hstepB + kstep, voffB);
        PG8_WAIT_V(6); PG8_BAR;
    } else {
        PG8_STAGE(PG8_SB(0, 0), cB, voffB); PG8_STAGE(PG8_SA(0, 0), cA, voffA); PG8_STAGE(PG8_SB(0, 1), cB + hstepB, voffB); PG8_STAGE(PG8_SA(0, 1), cA + hstepA, voffA);
        if (wr == 1) PG8_BAR;
        PG8_WAIT_V(4); PG8_BAR;
        PG8_STAGE(PG8_SB(1, 0), cB + kstep, voffB); PG8_STAGE(PG8_SA(1, 0), cA + kstep, voffA); PG8_STAGE(PG8_SB(1, 1), cB + hstepB + kstep, voffB);
        PG8_WAIT_V(6); PG8_BAR;
    }
    for (;;) {
        const bool has_next = S.next(ui + 1, nxt);
        const char* nA = has_next ? (const char*)g.A + (size_t)nxt.pm * tstepA : cA; const char* nB = has_next ? (const char*)g.Bt + (size_t)nxt.pn * tstepB : cB;
        for (int t = 0; t < nt; t += 2) {
            const bool last = (t == nt - 2);
            const char* a1 = cA + (size_t)(t + 1) * kstep;
            const char* a2 = last ? nA : cA + (size_t)(t + 2) * kstep; const char* b2 = last ? nB : cB + (size_t)(t + 2) * kstep;
            const char* a3 = a2 + kstep; const char* b3 = b2 + kstep;
            if (last && has_next) S.a_ready(nxt);
            if constexpr (SP2) {
            PG8_LDB(B0, 0, 0); PG8_LDB(B1, 0, 1); PG8_SCHED; PG8_LDA(At, 0, 0); PG8_STAGE(PG8_SA(1, 1), a1 + hstepA, voffA);
            PG8_WAIT_V(8); PG8_WAIT_L(0); PG8_BAR; PG8_MMA(0, 0, At, B0); PG8_MMA(0, 1, At, B1); PG8_BAR; PG8_SCHED;
            PG8_LDA(At, 0, 1); PG8_STAGE(PG8_SB(0, 0), b2, voffB); PG8_STAGE(PG8_SB(0, 1), b2 + hstepB, voffB); PG8_STAGE(PG8_SA(0, 0), a2, voffA);
            PG8_WAIT_V(8); PG8_WAIT_L(0); PG8_BAR; PG8_MMA(1, 0, At, B0); PG8_MMA(1, 1, At, B1); PG8_BAR; PG8_SCHED;
            PG8_LDB(B0, 1, 0); PG8_LDB(B1, 1, 1); PG8_SCHED; PG8_LDA(At, 1, 0); PG8_STAGE(PG8_SA(0, 1), a2 + hstepA, voffA);
            PG8_WAIT_V(8); PG8_WAIT_L(0); PG8_BAR; PG8_MMA(0, 0, At, B0); PG8_MMA(0, 1, At, B1); PG8_BAR; PG8_SCHED;
            PG8_LDA(At, 1, 1); PG8_STAGE(PG8_SB(1, 0), b3, voffB); PG8_STAGE(PG8_SB(1, 1), b3 + hstepB, voffB); PG8_STAGE(PG8_SA(1, 0), a3, voffA);
            PG8_WAIT_V(8); PG8_WAIT_L(0); PG8_BAR; PG8_MMA(1, 0, At, B0); PG8_MMA(1, 1, At, B1); PG8_BAR; PG8_SCHED;
            } else {
            PG8_LDB(B0, 0, 0); PG8_SCHED; PG8_LDA(At, 0, 0); PG8_STAGE(PG8_SA(1, 1), a1 + hstepA, voffA);
            PG8_WAIT_L(8); PG8_BAR; PG8_WAIT_L(0); PG8_MMA(0, 0, At, B0); PG8_BAR; PG8_SCHED;
            PG8_LDB(B1, 0, 1); PG8_STAGE(PG8_SB(0, 0), b2, voffB);
            PG8_BAR; PG8_WAIT_L(0); PG8_MMA(0, 1, At, B1); PG8_BAR;
            PG8_LDA(At, 0, 1); PG8_STAGE(PG8_SA(0, 0), a2, voffA);
            PG8_BAR; PG8_WAIT_L(0); PG8_MMA(1, 0, At, B0); PG8_BAR; PG8_SCHED;
            PG8_STAGE(PG8_SB(0, 1), b2 + hstepB, voffB);
            PG8_WAIT_V(6); PG8_BAR; PG8_MMA(1, 1, At, B1); PG8_BAR;
            PG8_LDB(B0, 1, 0); PG8_SCHED; PG8_LDA(At, 1, 0); PG8_STAGE(PG8_SA(0, 1), a2 + hstepA, voffA);
            PG8_WAIT_L(8); PG8_BAR; PG8_WAIT_L(0); PG8_MMA(0, 0, At, B0); PG8_BAR; PG8_SCHED;
            PG8_LDB(B1, 1, 1); PG8_STAGE(PG8_SB(1, 0), b3, voffB);
            PG8_BAR; PG8_WAIT_L(0); PG8_MMA(0, 1, At, B1); PG8_BAR;
            PG8_LDA(At, 1, 1); PG8_STAGE(PG8_SA(1, 0), a3, voffA);
            PG8_BAR; PG8_WAIT_L(0); PG8_MMA(1, 0, At, B0); PG8_BAR; PG8_SCHED;
            PG8_STAGE(PG8_SB(1, 1), b3 + hstepB, voffB);
            PG8_WAIT_V(6); PG8_BAR; PG8_MMA(1, 1, At, B1); PG8_BAR;
            }
        }
        if constexpr (ALIGN_EPI) { if (wr == 0) PG8_BAR; }
        if constexpr (!Epi::AFTER_DRAIN) { if constexpr (Epi::USES_LDS) E.run(acc, cur, wr, wc, fr, fq, lds + STAGE_BYTES + 2048, wid, lane); else E(acc, cur, wr, wc, fr, fq); S.done(cur); }
        if (!has_next) break;
#pragma unroll
        for (int a = 0; a < 2; ++a)
#pragma unroll
            for (int b = 0; b < 2; ++b)
#pragma unroll
                for (int m = 0; m < 4; ++m)
#pragma unroll
                    for (int n = 0; n < 2; ++n) acc[a][b][m][n] = (f32x4){0.f, 0.f, 0.f, 0.f};
        cur = nxt; cA = nA; cB = nB; ++ui;
        if constexpr (ALIGN_EPI) { if (wr == 1) PG8_BAR; }
    }
    PG8_WAIT_V(0);
    if constexpr (!ALIGN_EPI) { if (wr == 0) PG8_BAR; }
    PG8_BAR;
    if constexpr (Epi::AFTER_DRAIN) { E.fused(acc, cur, wr, wc, fr, fq, lds, wid, lane); S.done(cur); }
#undef PG8_SA
#undef PG8_SB
#undef PG8_STAGE
#undef PG8_LDA
#undef PG8_LDB
#undef PG8_MMA
#undef PG8_WAIT_V
#undef PG8_WAIT_L
#undef PG8_BAR
#undef PG8_SCHED
}
}
namespace att {
using bf16 = unsigned short;
using bf16x8 = __attribute__((ext_vector_type(8))) short;
using s16x4  = __attribute__((ext_vector_type(4))) short;
using f32x16 = __attribute__((ext_vector_type(16))) float;
using u32x4  = __attribute__((ext_vector_type(4))) unsigned;
constexpr int NW = 8, QBLK = 32, KVBLK = 64, DV = 128;
constexpr float THR = 8.f;
#define SBAR() __builtin_amdgcn_sched_barrier(0)
__device__ __forceinline__ int crow(int r, int hi) { return (r & 3) + 8 * (r >> 2) + 4 * hi; }
__device__ __forceinline__ unsigned cvtpk(float lo, float hi) { unsigned r; asm volatile("v_cvt_pk_bf16_f32 %0, %1, %2" : "=v"(r) : "v"(lo), "v"(hi)); return r; }
__device__ __forceinline__ bf16x8 ld8(const bf16* p) { return *(const __attribute__((address_space(1))) bf16x8*)p; }

__device__ __forceinline__ void partialSM(f32x16& p0, f32x16& p1, float& m_reg, float& mn, float& alpha, const float C, const float THRS) {
  float pmax = p0[0];
#pragma unroll
  for (int r = 1; r < 16; ++r) pmax = fmaxf(pmax, p0[r]);
#pragma unroll
  for (int r = 0; r < 16; ++r) pmax = fmaxf(pmax, p1[r]);
  { auto rr = __builtin_amdgcn_permlane32_swap(__float_as_uint(pmax), __float_as_uint(pmax), false, false);
    pmax = fmaxf(__uint_as_float(rr[0]), __uint_as_float(rr[1])); }
  if (__builtin_expect(__all(pmax - m_reg <= THRS), 1)) { mn = m_reg; alpha = 1.f; }
  else { mn = fmaxf(m_reg, pmax); alpha = __builtin_amdgcn_exp2f((m_reg - mn) * C); m_reg = mn; }
  float mnC = -mn * C;
#pragma unroll
  for (int r = 0; r < 16; ++r) p0[r] = fmaf(p0[r], C, mnC);
#pragma unroll
  for (int r = 0; r < 16; ++r) p1[r] = fmaf(p1[r], C, mnC);
#pragma unroll
  for (int r = 0; r < 16; ++r) p0[r] = __builtin_amdgcn_exp2f(p0[r]);
}
#define PK4(P, BASE, OUT) do { unsigned a0 = cvtpk(P[BASE + 0], P[BASE + 1]), a1 = cvtpk(P[BASE + 2], P[BASE + 3]);   \
    unsigned b0 = cvtpk(P[BASE + 4], P[BASE + 5]), b1 = cvtpk(P[BASE + 6], P[BASE + 7]);                              \
    auto r0 = __builtin_amdgcn_permlane32_swap(a0, b0, false, false); auto r1 = __builtin_amdgcn_permlane32_swap(a1, b1, false, false); \
    u32x4 w = {r0[0], r1[0], r0[1], r1[1]}; OUT = *reinterpret_cast<bf16x8*>(&w); } while (0)
__device__ __forceinline__ void finishSM(f32x16& p0, f32x16& p1, float alpha, float& l_reg, bf16x8& pa0, bf16x8& pa1, bf16x8& pa2, bf16x8& pa3) {
#pragma unroll
  for (int r = 0; r < 16; ++r) p1[r] = __builtin_amdgcn_exp2f(p1[r]);
  float ps = 0;
#pragma unroll
  for (int r = 0; r < 16; ++r) ps += p0[r];
#pragma unroll
  for (int r = 0; r < 16; ++r) ps += p1[r];
  { auto rr = __builtin_amdgcn_permlane32_swap(__float_as_uint(ps), __float_as_uint(ps), false, false);
    ps = __uint_as_float(rr[0]) + __uint_as_float(rr[1]); }
  l_reg = l_reg * alpha + ps;
  PK4(p0, 0, pa0); PK4(p0, 8, pa1); PK4(p1, 0, pa2); PK4(p1, 8, pa3);
}
template <int DK> __device__ __forceinline__ int kswz(int row, int colB) {
  if (DK == 128) return row * 256 + (colB ^ ((row & 15) << 4));
  return (colB < 256) ? (row * 256 + (colB ^ ((row & 15) << 4))) : (64 * 256 + row * 128 + ((colB - 256) ^ ((row & 7) << 4)));
}
template <int DK> __device__ __forceinline__ void qkt(f32x16& p0, f32x16& p1, const char* Ks, const bf16x8* qr, int r32, int hi) {
  p0 = f32x16{}; p1 = f32x16{};
#pragma unroll
  for (int d0 = 0; d0 < DK / 16; ++d0) { int cb = (d0 * 16 + hi * 8) * 2;
    bf16x8 b0 = *reinterpret_cast<const bf16x8*>(Ks + kswz<DK>(r32, cb));
    bf16x8 b1 = *reinterpret_cast<const bf16x8*>(Ks + kswz<DK>(32 + r32, cb));
    p0 = __builtin_amdgcn_mfma_f32_32x32x16_bf16(b0, qr[d0], p0, 0, 0, 0);
    p1 = __builtin_amdgcn_mfma_f32_32x32x16_bf16(b1, qr[d0], p1, 0, 0, 0); }
}
__device__ __forceinline__ int v_st(int k, int c) { const int kk = (k & ~0xC) | ((k & 4) << 1) | ((k & 8) >> 1); return ((kk >> 3) * 4 + (c >> 5)) * 512 + ((kk & 7) * 32 + (c & 31)) * 2; }
__device__ __forceinline__ int v_rd_base(int lane) { return ((lane & 3) << 3) | (((lane >> 2) & 3) << 6) | (((lane >> 4) & 1) << 5) | (((lane >> 5) & 1) << 8); }
constexpr int v_rd_off(int d0, int ks, int half) { return d0 * 512 + ks * 4096 + half * 2048; }
template <int OFF> __device__ __forceinline__ s16x4 tr_read(int vb) {
  s16x4 r; asm volatile("ds_read_b64_tr_b16 %0, %1 offset:%2" : "=&v"(r) : "v"(vb), "i"(OFF) : "memory"); return r;
}
#define PKV(L, H) (bf16x8){L[0], L[1], L[2], L[3], H[0], H[1], H[2], H[3]}
template <int D0> __device__ __forceinline__ void pv_one(f32x16& od, int vb, bf16x8 pa0, bf16x8 pa1, bf16x8 pa2, bf16x8 pa3) {
  const s16x4 l0 = tr_read<v_rd_off(D0, 0, 0)>(vb), h0 = tr_read<v_rd_off(D0, 0, 1)>(vb), l1 = tr_read<v_rd_off(D0, 1, 0)>(vb), h1 = tr_read<v_rd_off(D0, 1, 1)>(vb);
  const s16x4 l2 = tr_read<v_rd_off(D0, 2, 0)>(vb), h2 = tr_read<v_rd_off(D0, 2, 1)>(vb), l3 = tr_read<v_rd_off(D0, 3, 0)>(vb), h3 = tr_read<v_rd_off(D0, 3, 1)>(vb);
  asm volatile("s_waitcnt lgkmcnt(0)" ::: "memory"); SBAR();
  od = __builtin_amdgcn_mfma_f32_32x32x16_bf16(pa0, PKV(l0, h0), od, 0, 0, 0);
  od = __builtin_amdgcn_mfma_f32_32x32x16_bf16(pa1, PKV(l1, h1), od, 0, 0, 0);
  od = __builtin_amdgcn_mfma_f32_32x32x16_bf16(pa2, PKV(l2, h2), od, 0, 0, 0);
  od = __builtin_amdgcn_mfma_f32_32x32x16_bf16(pa3, PKV(l3, h3), od, 0, 0, 0);
}
__device__ __forceinline__ void pv_d0(f32x16* o, int vb, bf16x8 pa0, bf16x8 pa1, bf16x8 pa2, bf16x8 pa3) {
  pv_one<0>(o[0], vb, pa0, pa1, pa2, pa3); pv_one<1>(o[1], vb, pa0, pa1, pa2, pa3); pv_one<2>(o[2], vb, pa0, pa1, pa2, pa3); pv_one<3>(o[3], vb, pa0, pa1, pa2, pa3);
}

template <int DK, int ldq, int ldk, int ldv, int ldo>
__device__ __forceinline__ void attn_dense_unit(const bf16* __restrict__ Qb, const bf16* __restrict__ Kh, const bf16* __restrict__ Vh,
                                                bf16* __restrict__ Ob, const float scale, char* lds, const int seqr, const float* __restrict__ ropetab) {
  constexpr int SHM_V = KVBLK * DV * 2, SHM_K = KVBLK * DK * 2, NQ = DK / 16, NKC = DK / 64;
  const float C = scale * 1.4426950408889634f, THRS = THR / scale;
  int tid_ = threadIdx.x; asm volatile("" : "+v"(tid_));
  const int tid = tid_, wid = tid >> 6, lane = tid & 63, r32 = lane & 31, hi = lane >> 5;
  char* V_lds = lds; char* K_lds = lds + 2 * SHM_V;
  float* ws = (float*)(lds + 2 * SHM_V + 2 * SHM_K) + wid * 64; float* li_l = ws; float* al_l = ws + 32;
  float m_reg = -1e30f, l_reg = 0; f32x16 o[4] = {}; bf16x8 qr[NQ];
  const int sr = tid >> 4, sc = (tid & 15) * 8, vst0 = v_st(sr, sc), vst1 = v_st(32 + sr, sc);
  int krow[NKC], kcol[NKC];
#pragma unroll
  for (int i = 0; i < NKC; ++i) { const int c = tid + 512 * i; krow[i] = c / (DK / 8); kcol[i] = (c % (DK / 8)) * 8; }
  const int vb0 = (int)(uintptr_t)V_lds + v_rd_base(lane);
  bf16x8 vs0, vs1, ks[NKC];
#define SLOAD(k0) do { vs0 = ld8(&Vh[(long)((k0) + sr) * ldv + sc]); vs1 = ld8(&Vh[(long)((k0) + 32 + sr) * ldv + sc]); \
    _Pragma("unroll") for (int i_ = 0; i_ < NKC; ++i_) ks[i_] = ld8(&Kh[(long)((k0) + krow[i_]) * ldk + kcol[i_]]); } while (0)
#define SWRITE(b) do { *(bf16x8*)(V_lds + (b) * SHM_V + vst0) = vs0; *(bf16x8*)(V_lds + (b) * SHM_V + vst1) = vs1; \
    _Pragma("unroll") for (int i_ = 0; i_ < NKC; ++i_) *(bf16x8*)(K_lds + (b) * SHM_K + kswz<DK>(krow[i_], kcol[i_] * 2)) = ks[i_]; } while (0)
  SLOAD(0); asm volatile("" ::: "memory");
  const bf16* Qw = Qb + (long)(wid * QBLK + r32) * ldq + hi * 8;
#pragma unroll
  for (int d0 = 0; d0 < NQ; ++d0) qr[d0] = ld8(Qw + d0 * 16);
  if constexpr (DK == 192) {
    const float* tp = ropetab + ((long)(wid * QBLK + r32) * 32 + hi * 8) * 2;
    u32x4 tq[2][4];
#pragma unroll
    for (int k = 0; k < 2; ++k)
#pragma unroll
      for (int w = 0; w < 4; ++w) tq[k][w] = *reinterpret_cast<const u32x4*>(tp + k * 32 + w * 4);
    asm volatile("" : "+v"(tq[0][0]), "+v"(tq[0][1]), "+v"(tq[0][2]), "+v"(tq[0][3]), "+v"(tq[1][0]), "+v"(tq[1][1]), "+v"(tq[1][2]), "+v"(tq[1][3]));
#pragma unroll
    for (int k = 0; k < 2; ++k) {
      u32x4 a = *reinterpret_cast<u32x4*>(&qr[8 + k]), b = *reinterpret_cast<u32x4*>(&qr[10 + k]); u32x4 oa, ob;
#pragma unroll
      for (int w = 0; w < 4; ++w) { float4 t; t.x = __uint_as_float(tq[k][w].x); t.y = __uint_as_float(tq[k][w].y); t.z = __uint_as_float(tq[k][w].z); t.w = __uint_as_float(tq[k][w].w);
        const float x1l = __uint_as_float(a[w] << 16), x1h = __uint_as_float(a[w] & 0xffff0000u), x2l = __uint_as_float(b[w] << 16), x2h = __uint_as_float(b[w] & 0xffff0000u);
        oa[w] = cvtpk(x1l * t.x - x2l * t.y, x1h * t.z - x2h * t.w); ob[w] = cvtpk(x1l * t.y + x2l * t.x, x1h * t.w + x2h * t.z); }
      qr[8 + k] = *reinterpret_cast<bf16x8*>(&oa); qr[10 + k] = *reinterpret_cast<bf16x8*>(&ob); } }
  const int NT = seqr / KVBLK;
  SWRITE(0); __syncthreads();
  for (int j = 0; j < NT; ++j) {
    const int cb = j & 1;
    if (j + 1 < NT) SLOAD((j + 1) * KVBLK);
    SBAR();
    f32x16 p0, p1; float mn, al; bf16x8 pa0, pa1, pa2, pa3;
    qkt<DK>(p0, p1, K_lds + cb * SHM_K, qr, r32, hi);
    partialSM(p0, p1, m_reg, mn, al, C, THRS);
    if (__any(al < 1.f)) { if (hi == 0) al_l[r32] = al; asm volatile("s_waitcnt lgkmcnt(0)" ::: "memory");
#pragma unroll
      for (int d = 0; d < 4; ++d)
#pragma unroll
        for (int r = 0; r < 16; ++r) o[d][r] *= al_l[crow(r, hi)]; }
    finishSM(p0, p1, al, l_reg, pa0, pa1, pa2, pa3); SBAR();
    pv_d0(o, vb0 + cb * SHM_V, pa0, pa1, pa2, pa3);
    SBAR();
    if (j + 1 < NT) SWRITE(cb ^ 1);
    __syncthreads();
  }
  if (hi == 0) li_l[r32] = l_reg; asm volatile("s_waitcnt lgkmcnt(0)" ::: "memory");
  float rli[16];
#pragma unroll
  for (int r = 0; r < 16; ++r) rli[r] = __builtin_amdgcn_rcpf(li_l[crow(r, hi)]);
  bf16* Ow = Ob + (long)(wid * QBLK) * ldo;
#pragma unroll
  for (int r = 0; r < 16; ++r) { int orow = crow(r, hi);
#pragma unroll
    for (int d0 = 0; d0 < 4; ++d0) Ow[(long)orow * ldo + d0 * 32 + r32] = (bf16)(cvtpk(o[d0][r] * rli[r], 0.f) & 0xffffu); }
  __syncthreads();
#undef SLOAD
#undef SWRITE
}

__device__ __forceinline__ void banded_wave_unit(const bf16* __restrict__ Q, long qs, const bf16* __restrict__ K, long ks, const bf16* __restrict__ V, long vs,
                                                 int i0, int L, bf16* __restrict__ O, long os, float* __restrict__ LSE, long ls, char* wlds) {
  constexpr float SCALE = 0.088388347648318440f, C = SCALE * 1.4426950408889634f;
  int tid_ = threadIdx.x; asm volatile("" : "+v"(tid_));
  const int lane = tid_ & 63, r32 = lane & 31, hi = lane >> 5;
  float* ex = (float*)(wlds + 8192);
  const int vb = (int)(uintptr_t)wlds + v_rd_base(lane);
  bf16x8 qr[8];
  { const bf16* Qw = Q + (long)(i0 + r32) * qs + hi * 8;
#pragma unroll
    for (int d0 = 0; d0 < 8; ++d0) qr[d0] = ld8(Qw + d0 * 16); }
  float m_reg = -1e30f, l_reg = 0.f; f32x16 o[4] = {};
  for (int tt = -2; tt <= 2; ++tt) {
    const int j0 = i0 + 32 * tt;
    if (j0 < 0 || j0 >= L) continue;
    bf16x8 vr[8], kf[8];
#pragma unroll
    for (int i = 0; i < 8; ++i) { const int idx = lane + 64 * i; vr[i] = ld8(V + (long)(j0 + (idx >> 4)) * vs + (idx & 15) * 8); }
    { const bf16* Kw = K + (long)(j0 + r32) * ks + hi * 8;
#pragma unroll
      for (int d0 = 0; d0 < 8; ++d0) kf[d0] = ld8(Kw + d0 * 16); }
    f32x16 p = f32x16{};
#pragma unroll
    for (int d0 = 0; d0 < 8; ++d0) p = __builtin_amdgcn_mfma_f32_32x32x16_bf16(kf[d0], qr[d0], p, 0, 0, 0);
    if (tt == -2) {
#pragma unroll
      for (int r = 0; r < 16; ++r) if (crow(r, hi) < r32) p[r] = -INFINITY; }
    if (tt == 2) {
#pragma unroll
      for (int r = 0; r < 16; ++r) if (crow(r, hi) > r32) p[r] = -INFINITY; }
    float pmax = p[0];
#pragma unroll
    for (int r = 1; r < 16; ++r) pmax = fmaxf(pmax, p[r]);
    { auto rr = __builtin_amdgcn_permlane32_swap(__float_as_uint(pmax), __float_as_uint(pmax), false, false);
      pmax = fmaxf(__uint_as_float(rr[0]), __uint_as_float(rr[1])); }
    const float mn = fmaxf(m_reg, pmax), alpha = __builtin_amdgcn_exp2f((m_reg - mn) * C); m_reg = mn;
    const float mnC = -mn * C; float ps = 0.f;
#pragma unroll
    for (int r = 0; r < 16; ++r) { p[r] = __builtin_amdgcn_exp2f(fmaf(p[r], C, mnC)); ps += p[r]; }
    { auto rr = __builtin_amdgcn_permlane32_swap(__float_as_uint(ps), __float_as_uint(ps), false, false);
      ps = __uint_as_float(rr[0]) + __uint_as_float(rr[1]); }
    l_reg = l_reg * alpha + ps;
    bf16x8 pa0, pa1; PK4(p, 0, pa0); PK4(p, 8, pa1);
    if (hi == 0) ex[r32] = alpha;
#pragma unroll
    for (int i = 0; i < 8; ++i) { const int idx = lane + 64 * i; *(bf16x8*)(wlds + v_st(idx >> 4, (idx & 15) * 8)) = vr[i]; }
    asm volatile("s_waitcnt lgkmcnt(0)" ::: "memory"); SBAR();
#pragma unroll
    for (int d = 0; d < 4; ++d)
#pragma unroll
      for (int r = 0; r < 16; ++r) o[d][r] *= ex[crow(r, hi)];
#define PV2(D0) do { const s16x4 l0 = tr_read<v_rd_off(D0, 0, 0)>(vb), h0 = tr_read<v_rd_off(D0, 0, 1)>(vb), l1 = tr_read<v_rd_off(D0, 1, 0)>(vb), h1 = tr_read<v_rd_off(D0, 1, 1)>(vb); \
      asm volatile("s_waitcnt lgkmcnt(0)" ::: "memory"); SBAR(); \
      o[D0] = __builtin_amdgcn_mfma_f32_32x32x16_bf16(pa0, PKV(l0, h0), o[D0], 0, 0, 0); \
      o[D0] = __builtin_amdgcn_mfma_f32_32x32x16_bf16(pa1, PKV(l1, h1), o[D0], 0, 0, 0); } while (0)
    PV2(0); PV2(1); PV2(2); PV2(3);
#undef PV2
    asm volatile("s_waitcnt lgkmcnt(0)" ::: "memory"); SBAR();
  }
  if (hi == 0) { ex[32 + r32] = l_reg; LSE[(long)(i0 + r32) * ls] = m_reg * SCALE + __logf(l_reg); }
  asm volatile("s_waitcnt lgkmcnt(0)" ::: "memory"); SBAR();
  float rli[16];
#pragma unroll
  for (int r = 0; r < 16; ++r) rli[r] = __builtin_amdgcn_rcpf(ex[32 + crow(r, hi)]);
#pragma unroll
  for (int r = 0; r < 16; ++r) { const int orow = crow(r, hi);
#pragma unroll
    for (int d0 = 0; d0 < 4; ++d0) O[(long)(i0 + orow) * os + d0 * 32 + r32] = (bf16)(cvtpk(o[d0][r] * rli[r], 0.f) & 0xffffu); }
  asm volatile("s_waitcnt lgkmcnt(0)" ::: "memory"); SBAR();
}
#undef PK4
#undef PKV
#undef SBAR
}
#define LAS __attribute__((address_space(3)))
typedef unsigned short bf16;
typedef unsigned v4u __attribute__((ext_vector_type(4)));
typedef unsigned v2u __attribute__((ext_vector_type(2)));
typedef float f32x4 __attribute__((ext_vector_type(4)));

constexpr int NB = 4, SEQ = 2048, T = NB * SEQ, DM = 2048, DEPTH = 2;
constexpr int NIN = 4928, NINP = 5120, NUQ = 1152, NUQP = 1280, NUKV = 1536, DFF = 5632, NUP = 2 * DFF, CQR = 512;
constexpr int AQ_OFF = 0, AK_OFF = 768, AV_OFF = 1024, BQ_OFF = 1280, BK_OFF = 2816, BV_OFF = 3328, CQ_OFF = 3840, CKV_OFF = 4352, CKR_OFF = 4864;
constexpr float EPS = 1e-6f;
constexpr int NWAVES = 8, NTHR = 512;
constexpr int LDS_BYTES = 147456;

constexpr size_t MiB = 1u << 20;
constexpr size_t SZ_WIN = (size_t)NINP * DM * 2, SZ_WUQ = (size_t)NUQP * CQR * 2, SZ_WUKV = (size_t)NUKV * CQR * 2, SZ_WOUT = (size_t)DM * DM * 2, SZ_WUP = (size_t)NUP * DM * 2, SZ_WDN = (size_t)DM * DFF * 2;
constexpr size_t WL_IN = 0, WL_UQ = WL_IN + SZ_WIN, WL_UKV = WL_UQ + SZ_WUQ, WL_OUT = WL_UKV + SZ_WUKV, WL_UP = WL_OUT + SZ_WOUT, WL_DN = WL_UP + SZ_WUP, WL_SIZE = WL_DN + SZ_WDN;
constexpr size_t WS_TAB = 1 * MiB;
constexpr int TAB_ROW = 0, TAB_COL = 32 * 32, TAB_PART = TAB_COL + 64 * 32, TAB_MLA = TAB_PART + SEQ * 16, TAB_N = TAB_MLA + SEQ * 32;
constexpr size_t WS_W = 2 * MiB;
constexpr size_t CTL_ZERO_BYTES = 65536;
constexpr int CW_NORM = 8192;
constexpr int CW_BAR = 1024, LDS_MISC_OFF = 131072 + 1024, LDS_ARG_OFF = 131072 + 512;
constexpr size_t WS_XN = WS_W + 2 * WL_SIZE;
constexpr size_t WS_X = WS_XN + (size_t)T * DM * 2;
constexpr size_t WS_R1 = WS_X + (size_t)T * DM * 4;
constexpr size_t WS_PROJ = WS_R1;
constexpr size_t WS_QC = WS_PROJ + (size_t)T * NINP * 2;
constexpr size_t WS_KC = WS_QC + (size_t)T * NUQ * 2;
constexpr size_t WS_VC = WS_KC + (size_t)T * NUQ * 2;
constexpr size_t WS_OB = WS_VC + (size_t)T * 768 * 2;
constexpr size_t WS_LSE = WS_OB + (size_t)3 * T * 512 * 4;
constexpr size_t WS_R1_END = WS_LSE + (size_t)3 * T * 4 * 4;
constexpr size_t WS_H = WS_R1;
constexpr size_t WS_H_END = WS_H + (size_t)T * NUP * 2;
constexpr size_t WS_R2 = (WS_R1_END > WS_H_END ? WS_R1_END : WS_H_END);
constexpr size_t WS_Y = WS_R2;
constexpr size_t WS_YN = WS_Y + (size_t)T * DM * 4;
constexpr size_t WS_ACT = WS_R2;
constexpr size_t WS_X2 = WS_YN + (size_t)T * DM * 2;
constexpr size_t WS_HB = WS_X2 + (size_t)T * DM * 4;
constexpr size_t WS_XB = WS_HB + (size_t)(T / 256) * 4 * NUP * 4;
constexpr size_t WS_SSL = WS_XB + (size_t)4 * T * 8 * 4;
constexpr size_t WS_END = WS_SSL + (size_t)2 * T * 8 * 4;
static_assert((size_t)T * DFF * 2 <= (size_t)T * DM * 6, "ACT fits over Y|YN");
static_assert((size_t)TAB_N * 8 <= MiB, "tables fit");
static_assert(WS_W % 256 == 0 && WL_SIZE % 256 == 0 && WS_R2 % 256 == 0, "alignment");

struct Args {
    const float *x, *attn_norm, *w_in, *a_q_norm, *a_k_norm, *c_q_norm, *c_kv_norm, *w_uq, *w_ukv, *out_norm, *w_out, *ffn_norm, *w_up, *conv_w, *conv_b, *w_down, *final_norm;
    float* out; unsigned char* ws; int ph_lo, ph_hi;
};

__device__ __forceinline__ unsigned f2bf(float f) { unsigned u = __builtin_bit_cast(unsigned, f); return (u + 0x7fffu + ((u >> 16) & 1u)) >> 16; }
__device__ __forceinline__ unsigned pk2(float lo, float hi) { return f2bf(lo) | (f2bf(hi) << 16); }
__device__ __forceinline__ float bf2f(unsigned short h) { return __builtin_bit_cast(float, (unsigned)h << 16); }
__device__ __forceinline__ float bflo(unsigned w) { return __builtin_bit_cast(float, w << 16); }
__device__ __forceinline__ float bfhi(unsigned w) { return __builtin_bit_cast(float, w & 0xffff0000u); }
__device__ __forceinline__ float wave_sum(float v) {
#pragma unroll
    for (int o = 1; o < 64; o <<= 1) v += __shfl_xor(v, o);
    return v;
}

template <bool FFN_PERM = false>
__device__ __forceinline__ void p0_transpose_item(const float* W, int K, int N, bf16* WT, float*  , int item, int lane, const float* gain = nullptr) {
    const int nblk = N / 64, kb0 = item / nblk, nb = item % nblk, k0 = 64 * kb0, n0 = 64 * nb, kb = lane >> 4, nq = lane & 15;
    const int d0 = FFN_PERM ? (256 * ((n0 % DFF) / 128) + 128 * (n0 / DFF) + (n0 % DFF) % 128) : n0;
    const float* src = W + (size_t)(k0 + 8 * kb) * N + n0 + 4 * nq;
    bf16* dst = WT + (size_t)(d0 + 4 * nq) * K + k0 + 8 * kb;
    f32x4 v[2][8];
#pragma unroll
    for (int h = 0; h < 2; ++h)
#pragma unroll
        for (int j = 0; j < 8; ++j) v[h][j] = __builtin_nontemporal_load((const f32x4*)(src + (size_t)(32 * h + j) * N));
#pragma unroll
    for (int h = 0; h < 2; ++h) {
        if (gain) { const f32x4 g0 = *(const f32x4*)(gain + k0 + 32 * h + 8 * kb), g1 = *(const f32x4*)(gain + k0 + 32 * h + 8 * kb + 4);
            v[h][0] *= g0[0]; v[h][1] *= g0[1]; v[h][2] *= g0[2]; v[h][3] *= g0[3]; v[h][4] *= g1[0]; v[h][5] *= g1[1]; v[h][6] *= g1[2]; v[h][7] *= g1[3]; }
#pragma unroll
        for (int i = 0; i < 4; ++i) { v4u o; o.x = pk2(v[h][0][i], v[h][1][i]); o.y = pk2(v[h][2][i], v[h][3][i]); o.z = pk2(v[h][4][i], v[h][5][i]); o.w = pk2(v[h][6][i], v[h][7][i]);
            *(v4u*)(dst + (size_t)i * K + 32 * h) = o; }
    }
}
__device__ __forceinline__ void convert_out(const float* w_out, unsigned char* wb, int sub_w, int sub_n, int lane) {
    constexpr int I_OUT = (DM / 64) * (DM / 64);
    for (int it = sub_w; it < I_OUT; it += sub_n) p0_transpose_item(w_out, DM, DM, (bf16*)(wb + WL_OUT), nullptr, it, lane);
}
constexpr int I_UP_ALL = (DM / 64) * (NUP / 64), I_UP_SPLIT = I_UP_ALL * 3 / 4;
__device__ __forceinline__ void convert_up(const float* w_up, unsigned char* wb, int sub_w, int sub_n, int lane, int i0 = 0, int i1 = I_UP_ALL) {
    for (int it = i0 + sub_w; it < i1; it += sub_n) p0_transpose_item<true>(w_up, DM, NUP, (bf16*)(wb + WL_UP), nullptr, it, lane);
}
__device__ __forceinline__ void convert_down(const float* w_down, unsigned char* wb, int sub_w, int sub_n, int lane) {
    constexpr int I_DN = (DFF / 64) * (DM / 64);
    for (int it = sub_w; it < I_DN; it += sub_n) p0_transpose_item(w_down, DFF, DM, (bf16*)(wb + WL_DN), nullptr, it, lane);
}
__device__ __forceinline__ void convert_ffn(const float* w_up, const float* w_down, unsigned char* wb, int sub_w, int sub_n, int lane) {
    constexpr int I_UP = (DM / 64) * (NUP / 64), I_DN = (DFF / 64) * (DM / 64);
    for (int it = sub_w; it < I_UP + I_DN; it += sub_n) {
        if (it < I_UP) p0_transpose_item<true>(w_up, DM, NUP, (bf16*)(wb + WL_UP), nullptr, it, lane);
        else p0_transpose_item(w_down, DFF, DM, (bf16*)(wb + WL_DN), nullptr, it - I_UP, lane); }
}
__device__ __forceinline__ void rms_row_bf16(const float* xrow, const float* g, bf16* orow, int lane) {
    const f32x4* xr = (const f32x4*)xrow + lane; const f32x4* gr = (const f32x4*)g + lane;
    f32x4 v[8]; float s = 0.f;
#pragma unroll
    for (int j = 0; j < 8; ++j) { v[j] = __builtin_nontemporal_load(xr + 64 * j); s += (v[j].x * v[j].x + v[j].y * v[j].y) + (v[j].z * v[j].z + v[j].w * v[j].w); }
    const float rstd = 1.f / sqrtf(wave_sum(s) * (1.f / DM) + EPS);
    v2u* o8 = (v2u*)orow + lane;
#pragma unroll
    for (int j = 0; j < 8; ++j) { const f32x4 gg = gr[64 * j]; v2u w; w.x = pk2(v[j].x * rstd * gg.x, v[j].y * rstd * gg.y); w.y = pk2(v[j].z * rstd * gg.z, v[j].w * rstd * gg.w); o8[64 * j] = w; }
}
template <int NR>
__device__ __forceinline__ void rms_rows_bf16(const float* x0, size_t xstep, const float* g, bf16* o0, size_t ostep, int lane) {
    f32x4 v[NR][8], gg[8]; float s[NR];
#pragma unroll
    for (int r = 0; r < NR; ++r) { const f32x4* xr = (const f32x4*)(x0 + r * xstep) + lane;
#pragma unroll
        for (int j = 0; j < 8; ++j) v[r][j] = __builtin_nontemporal_load(xr + 64 * j); }
#pragma unroll
    for (int j = 0; j < 8; ++j) gg[j] = ((const f32x4*)g + lane)[64 * j];
    asm volatile("" : "+v"(gg[0]), "+v"(gg[1]), "+v"(gg[2]), "+v"(gg[3]), "+v"(gg[4]), "+v"(gg[5]), "+v"(gg[6]), "+v"(gg[7]));
#pragma unroll
    for (int r = 0; r < NR; ++r) { float t = 0.f;
#pragma unroll
        for (int j = 0; j < 8; ++j) t += (v[r][j].x * v[r][j].x + v[r][j].y * v[r][j].y) + (v[r][j].z * v[r][j].z + v[r][j].w * v[r][j].w);
        s[r] = 1.f / sqrtf(wave_sum(t) * (1.f / DM) + EPS); }
#pragma unroll
    for (int r = 0; r < NR; ++r) { v2u* o8 = (v2u*)(o0 + r * ostep) + lane; const float rstd = s[r];
#pragma unroll
        for (int j = 0; j < 8; ++j) { v2u w; w.x = pk2(v[r][j].x * rstd * gg[j].x, v[r][j].y * rstd * gg[j].y); w.y = pk2(v[r][j].z * rstd * gg[j].z, v[r][j].w * rstd * gg[j].w); o8[64 * j] = w; } }
}
__device__ __forceinline__ void rms_row_f32(const float* xrow, const float* g, float* orow, int lane) {
    const f32x4* xr = (const f32x4*)xrow + lane; const f32x4* gr = (const f32x4*)g + lane;
    f32x4 v[8]; float s = 0.f;
#pragma unroll
    for (int j = 0; j < 8; ++j) { v[j] = xr[64 * j]; s += (v[j].x * v[j].x + v[j].y * v[j].y) + (v[j].z * v[j].z + v[j].w * v[j].w); }
    const float rstd = 1.f / sqrtf(wave_sum(s) * (1.f / DM) + EPS);
    f32x4* o = (f32x4*)orow + lane;
#pragma unroll
    for (int j = 0; j < 8; ++j) { const f32x4 gg = gr[64 * j]; o[64 * j] = v[j] * rstd * gg; }
}
__device__ __forceinline__ void rmsb_row(const bf16* xrow, const float* g, bf16* obf, float* of32, int lane) {
    const v4u* xr = (const v4u*)xrow + lane; float f[4][8]; float s = 0.f;
#pragma unroll
    for (int j = 0; j < 4; ++j) { const v4u r = xr[64 * j]; f[j][0] = bflo(r.x); f[j][1] = bfhi(r.x); f[j][2] = bflo(r.y); f[j][3] = bfhi(r.y); f[j][4] = bflo(r.z); f[j][5] = bfhi(r.z); f[j][6] = bflo(r.w); f[j][7] = bfhi(r.w);
#pragma unroll
        for (int e = 0; e < 8; ++e) s += f[j][e] * f[j][e]; }
    const float rstd = 1.f / sqrtf(wave_sum(s) * (1.f / DM) + EPS);
#pragma unroll
    for (int j = 0; j < 4; ++j) { const int c = (lane + 64 * j) * 8; const f32x4 g0 = *(const f32x4*)(g + c), g1 = *(const f32x4*)(g + c + 4);
        const float y0 = f[j][0] * rstd * g0.x, y1 = f[j][1] * rstd * g0.y, y2 = f[j][2] * rstd * g0.z, y3 = f[j][3] * rstd * g0.w, y4 = f[j][4] * rstd * g1.x, y5 = f[j][5] * rstd * g1.y, y6 = f[j][6] * rstd * g1.z, y7 = f[j][7] * rstd * g1.w;
        if (obf) { v4u w; w.x = pk2(y0, y1); w.y = pk2(y2, y3); w.z = pk2(y4, y5); w.w = pk2(y6, y7); *(v4u*)(obf + c) = w; }
        else { __builtin_nontemporal_store((f32x4){y0, y1, y2, y3}, (f32x4*)(of32 + c)); __builtin_nontemporal_store((f32x4){y4, y5, y6, y7}, (f32x4*)(of32 + c + 4)); } }
}
__device__ __forceinline__ float inv_freq(float theta, int j2, int dim) { return powf(theta, -(float)j2 / (float)dim); }

__device__ __forceinline__ void unpack8(const v4u r, float* f) { f[0] = bflo(r.x); f[1] = bfhi(r.x); f[2] = bflo(r.y); f[3] = bfhi(r.y); f[4] = bflo(r.z); f[5] = bfhi(r.z); f[6] = bflo(r.w); f[7] = bfhi(r.w); }
typedef float f32x2 __attribute__((ext_vector_type(2)));
__device__ __forceinline__ v4u rope8(const float* y, const float* yp, bool first, const f32x2* cs) {
    float o[8];
#pragma unroll
    for (int e = 0; e < 8; ++e) { const f32x2 t = cs[e]; o[e] = first ? (y[e] * t.x - yp[e] * t.y) : (yp[e] * t.y + y[e] * t.x); }
    v4u w; w.x = pk2(o[0], o[1]); w.y = pk2(o[2], o[3]); w.z = pk2(o[4], o[5]); w.w = pk2(o[6], o[7]); return w;
}
__device__ __forceinline__ void prep_row(bf16* P, bf16* KCrow, int s, const float* aqn, const float* akn, const float*  , const float*  , const f32x2* tab, int lane) {
    const int l16 = lane & 15, hsel = lane >> 4, hhb = lane >> 2, cq = lane & 3, l8 = lane & 7;
    bf16* hpA0 = P + AQ_OFF + hsel * 128 + l16 * 8; bf16* hpA1 = P + AQ_OFF + (4 + hsel) * 128 + l16 * 8;
    bf16* hpB = P + BQ_OFF + hhb * 128 + cq * 8; bf16* kp = P + CKR_OFF + l8 * 8;
    const v4u rA0 = *(const v4u*)hpA0, rA1 = *(const v4u*)hpA1, rB = *(const v4u*)hpB, rK = *(const v4u*)kp;
    const f32x2* csA = tab + ((l16 < 8) ? (TAB_ROW + (s / 64) * 32) : (TAB_COL + (s % 64) * 32)) + (l16 & 3) * 8;
    const f32x2* csB = tab + TAB_PART + s * 16 + (cq & 1) * 8;
    const f32x2* csK = tab + TAB_MLA + s * 32 + (l8 & 3) * 8;
    f32x2 tA[8], tB[8], tK[8];
#pragma unroll
    for (int e = 0; e < 8; ++e) { tA[e] = csA[e]; tB[e] = csB[e]; tK[e] = csK[e]; }
    const float* g0 = aqn + l16 * 8; const float* g1 = ((4 + hsel < 6) ? aqn : akn) + l16 * 8;
    float ga[8], gb[8];
#pragma unroll
    for (int e = 0; e < 8; ++e) { ga[e] = g0[e]; gb[e] = g1[e]; }
    asm volatile("" ::: "memory");
    { const bool first = (l16 & 4) == 0;
#pragma unroll
      for (int it = 0; it < 2; ++it) { float f[8], y[8], yp[8]; unpack8(it ? rA1 : rA0, f);
          float ss = 0.f;
#pragma unroll
          for (int e = 0; e < 8; ++e) ss += f[e] * f[e];
          ss += __shfl_xor(ss, 1); ss += __shfl_xor(ss, 2); ss += __shfl_xor(ss, 4); ss += __shfl_xor(ss, 8);
          const float rstd = 1.f / sqrtf(ss * (1.f / 128.f) + EPS);
#pragma unroll
          for (int e = 0; e < 8; ++e) { y[e] = f[e] * rstd * (it ? gb[e] : ga[e]); yp[e] = __shfl_xor(y[e], 4); }
          *(v4u*)(it ? hpA1 : hpA0) = rope8(y, yp, first, tA); } }
    { const bool first = cq < 2; float y[8], yp[8]; unpack8(rB, y);
#pragma unroll
      for (int e = 0; e < 8; ++e) yp[e] = __shfl_xor(y[e], 2);
      *(v4u*)hpB = rope8(y, yp, first, tB); }
    { const bool first = l8 < 4; float y[8], yp[8]; unpack8(rK, y);
#pragma unroll
      for (int e = 0; e < 8; ++e) yp[e] = __shfl_xor(y[e], 4);
      const v4u w = rope8(y, yp, first, tK);
      if (lane < 8) { *(v4u*)kp = w;
#pragma unroll
          for (int h = 0; h < 6; ++h) *(v4u*)(KCrow + h * 192 + 128 + l8 * 8) = w; } }
}
__device__ __forceinline__ f32x4 ldbf4(const bf16* p) { const v2u r = *(const v2u*)p; return (f32x4){bflo(r.x), bfhi(r.x), bflo(r.y), bfhi(r.y)}; }
template <int NR>
__device__ __forceinline__ void outnorm_rows(const bf16* Y0, const bf16* OB, const float* LSE, int t0, int tstep, const float* g, bf16* YN0, int lane) {
    f32x4 a[NR][3], c[NR][3], o[NR][2][3], ga[3], gc[3], gb[2]; float ls[NR][2][3];
#pragma unroll
    for (int r = 0; r < NR; ++r) { const int t = t0 + r * tstep; const bf16* Yrow = Y0 + (size_t)r * tstep * DM;
#pragma unroll
        for (int k = 0; k < 3; ++k) { a[r][k] = ldbf4(Yrow + (lane + 64 * k) * 4); c[r][k] = ldbf4(Yrow + 1280 + (lane + 64 * k) * 4); }
#pragma unroll
        for (int k = 0; k < 2; ++k) { const int idx = lane + 64 * k, h = idx >> 5;
#pragma unroll
            for (int q = 0; q < 3; ++q) { ls[r][k][q] = LSE[((size_t)q * T + t) * 4 + h]; o[r][k][q] = ldbf4(OB + ((size_t)q * T + t) * 512 + idx * 4); } } }
#pragma unroll
    for (int k = 0; k < 3; ++k) { ga[k] = ((const f32x4*)g)[lane + 64 * k]; gc[k] = ((const f32x4*)(g + 1280))[lane + 64 * k]; }
#pragma unroll
    for (int k = 0; k < 2; ++k) gb[k] = ((const f32x4*)(g + 768))[lane + 64 * k];
    asm volatile("" : "+v"(ga[0]), "+v"(ga[1]), "+v"(ga[2]), "+v"(gc[0]), "+v"(gc[1]), "+v"(gc[2]), "+v"(gb[0]), "+v"(gb[1]));
#pragma unroll
    for (int r = 0; r < NR; ++r) { f32x4 b[2]; float sa = 0.f, sb = 0.f, scc = 0.f;
#pragma unroll
        for (int k = 0; k < 3; ++k) { sa += (a[r][k].x * a[r][k].x + a[r][k].y * a[r][k].y) + (a[r][k].z * a[r][k].z + a[r][k].w * a[r][k].w);
                                      scc += (c[r][k].x * c[r][k].x + c[r][k].y * c[r][k].y) + (c[r][k].z * c[r][k].z + c[r][k].w * c[r][k].w); }
#pragma unroll
        for (int k = 0; k < 2; ++k) { const float l0 = ls[r][k][0], l1 = ls[r][k][1], l2 = ls[r][k][2];
            const float mx = fmaxf(l0, fmaxf(l1, l2)); const float e0 = __expf(l0 - mx), e1 = __expf(l1 - mx), e2 = __expf(l2 - mx); const float inv = 1.f / (e0 + e1 + e2);
            b[k] = o[r][k][0] * (e0 * inv) + o[r][k][1] * (e1 * inv) + o[r][k][2] * (e2 * inv);
            sb += (b[k].x * b[k].x + b[k].y * b[k].y) + (b[k].z * b[k].z + b[k].w * b[k].w); }
        const float ra = 1.f / sqrtf(wave_sum(sa) * (1.f / 768.f) + EPS), rb = 1.f / sqrtf(wave_sum(sb) * (1.f / 512.f) + EPS), rc = 1.f / sqrtf(wave_sum(scc) * (1.f / 768.f) + EPS);
        bf16* YNrow = YN0 + (size_t)r * tstep * DM;
#pragma unroll
        for (int k = 0; k < 3; ++k) { const int idx = lane + 64 * k;
            v2u w; w.x = pk2(a[r][k].x * ra * ga[k].x, a[r][k].y * ra * ga[k].y); w.y = pk2(a[r][k].z * ra * ga[k].z, a[r][k].w * ra * ga[k].w); ((v2u*)YNrow)[idx] = w;
            v2u w2; w2.x = pk2(c[r][k].x * rc * gc[k].x, c[r][k].y * rc * gc[k].y); w2.y = pk2(c[r][k].z * rc * gc[k].z, c[r][k].w * rc * gc[k].w); ((v2u*)(YNrow + 1280))[idx] = w2; }
#pragma unroll
        for (int k = 0; k < 2; ++k) { const int idx = lane + 64 * k;
            v2u w; w.x = pk2(b[k].x * rb * gb[k].x, b[k].y * rb * gb[k].y); w.y = pk2(b[k].z * rb * gb[k].z, b[k].w * rb * gb[k].w); ((v2u*)(YNrow + 768))[idx] = w; } }
}
constexpr int CONV_R = 16;
__device__ __forceinline__ void convact_item(const bf16* H, const float* cw, const float* cb, bf16* ACT, int t0, int c8) {
    const int c = c8 * 8, s0 = t0 % SEQ;
    float wg[3][8], wu[3][8], bg[8], bu[8];
#pragma unroll
    for (int k = 0; k < 3; ++k) { const f32x4 a0 = *(const f32x4*)(cw + (size_t)k * NUP + c), a1 = *(const f32x4*)(cw + (size_t)k * NUP + c + 4), b0 = *(const f32x4*)(cw + (size_t)k * NUP + DFF + c), b1 = *(const f32x4*)(cw + (size_t)k * NUP + DFF + c + 4);
        wg[k][0] = a0.x; wg[k][1] = a0.y; wg[k][2] = a0.z; wg[k][3] = a0.w; wg[k][4] = a1.x; wg[k][5] = a1.y; wg[k][6] = a1.z; wg[k][7] = a1.w;
        wu[k][0] = b0.x; wu[k][1] = b0.y; wu[k][2] = b0.z; wu[k][3] = b0.w; wu[k][4] = b1.x; wu[k][5] = b1.y; wu[k][6] = b1.z; wu[k][7] = b1.w; }
    { const f32x4 a0 = *(const f32x4*)(cb + c), a1 = *(const f32x4*)(cb + c + 4), b0 = *(const f32x4*)(cb + DFF + c), b1 = *(const f32x4*)(cb + DFF + c + 4);
      bg[0] = a0.x; bg[1] = a0.y; bg[2] = a0.z; bg[3] = a0.w; bg[4] = a1.x; bg[5] = a1.y; bg[6] = a1.z; bg[7] = a1.w;
      bu[0] = b0.x; bu[1] = b0.y; bu[2] = b0.z; bu[3] = b0.w; bu[4] = b1.x; bu[5] = b1.y; bu[6] = b1.z; bu[7] = b1.w; }
    const bf16* hp = H + (size_t)t0 * NUP + c;
    v4u pg, pu, cg_, cu, ng, nu;
    const v4u z = (v4u){0u, 0u, 0u, 0u};
    if (s0 > 0) { pg = *(const v4u*)(hp - NUP); pu = *(const v4u*)(hp - NUP + DFF); } else { pg = z; pu = z; }
    cg_ = *(const v4u*)hp; cu = *(const v4u*)(hp + DFF);
#pragma unroll 4
    for (int r = 0; r < CONV_R; ++r) {
        if (s0 + r + 1 < SEQ) { ng = *(const v4u*)(hp + (size_t)(r + 1) * NUP); nu = *(const v4u*)(hp + (size_t)(r + 1) * NUP + DFF); } else { ng = z; nu = z; }
        float a0[8], a1[8], a2[8], b0[8], b1[8], b2[8], o[8];
        unpack8(pg, a0); unpack8(cg_, a1); unpack8(ng, a2); unpack8(pu, b0); unpack8(cu, b1); unpack8(nu, b2);
#pragma unroll
        for (int e = 0; e < 8; ++e) { const float g = bg[e] + wg[0][e] * a0[e] + wg[1][e] * a1[e] + wg[2][e] * a2[e], u = bu[e] + wu[0][e] * b0[e] + wu[1][e] * b1[e] + wu[2][e] * b2[e];
            o[e] = g / (1.f + __expf(-g)) * u; }
        v4u w; w.x = pk2(o[0], o[1]); w.y = pk2(o[2], o[3]); w.z = pk2(o[4], o[5]); w.w = pk2(o[6], o[7]);
        *(v4u*)(ACT + (size_t)(t0 + r) * DFF + c) = w;
        pg = cg_; pu = cu; cg_ = ng; cu = nu;
    }
}

#define XB_TMO      128
#define XB_XCNT(j)  (256  + 64 * (j))
#define XB_XSUB(j)  (1280 + 64 * (j))
#define XB_XGEN(j)  (2304 + 64 * (j))
#define XB_TOP      3328
#define XB_TOPGEN   3392
#define XCD_BAR_WORDS 3456
#define XB_SPIN_CAP (1u << 18)

__device__ __forceinline__ unsigned xb_ld(unsigned* p)              { return __hip_atomic_load(p, __ATOMIC_RELAXED, __HIP_MEMORY_SCOPE_AGENT); }
__device__ __forceinline__ unsigned xb_add(unsigned* p, unsigned v) { return __hip_atomic_fetch_add(p, v, __ATOMIC_RELAXED, __HIP_MEMORY_SCOPE_AGENT); }
__device__ __forceinline__ unsigned xb_xcc_id() { return (unsigned)__builtin_amdgcn_s_getreg((3 << 11) | 20) & 0xFu; }
#define XB_SPIN(cond, bar) do { unsigned _sp = 0; while (cond) { __builtin_amdgcn_s_sleep(1); \
    if ((++_sp & 255u) == 0u) { if (xb_ld(&(bar)[XB_TMO])) break; if (_sp > XB_SPIN_CAP) { atomicAdd(&(bar)[XB_TMO], 1u); break; } } } } while (0)

struct XcdBarrier {
    unsigned* bar; unsigned x;
    volatile LAS unsigned* st;
};

__device__ __forceinline__ XcdBarrier xcd_barrier_post(unsigned* bar, volatile LAS unsigned* st) {
    XcdBarrier b; b.bar = bar; b.x = xb_xcc_id(); b.st = st;
    if (threadIdx.x == 0) (void)xb_add(&bar[XB_XCNT(b.x)], 1u);
    return b;
}
__device__ __forceinline__ void xcd_barrier_complete(unsigned* bar, unsigned x, unsigned& nloc, unsigned& nx) {
    const unsigned G = gridDim.x * gridDim.y * gridDim.z;
    unsigned sum, cnt, mine, sp = 0u;
    for (;;) {
        sum = 0u; cnt = 0u; mine = 0u;
        unsigned cj[16];
#pragma unroll
        for (unsigned j = 0; j < 16; ++j) cj[j] = xb_ld(&bar[XB_XCNT(j)]);
        __builtin_amdgcn_sched_barrier(0);
#pragma unroll
        for (unsigned j = 0; j < 16; ++j) { const unsigned c = cj[j]; sum += c; cnt += (c > 0u) ? 1u : 0u; mine = (j == x) ? c : mine; }
        if (sum == G) break;
        __builtin_amdgcn_s_sleep(1);
        if ((++sp & 255u) == 0u) { if (xb_ld(&bar[XB_TMO])) break; if (sp > XB_SPIN_CAP) { atomicAdd(&bar[XB_TMO], 1u); break; } }
    }
    nloc = mine > 0u ? mine : 1u; nx = cnt > 0u ? cnt : 1u;
}

__device__ __forceinline__ void xcd_barrier(const XcdBarrier& b) {
    asm volatile("s_waitcnt vmcnt(0)" ::: "memory");
    __syncthreads();
    if (threadIdx.x == 0) {
        unsigned* bar = b.bar;
        __builtin_amdgcn_s_waitcnt(0);
        unsigned nloc = b.st[0], nx = b.st[1];
        if (nloc == 0u) { xcd_barrier_complete(bar, b.x, nloc, nx); b.st[0] = nloc; b.st[1] = nx; }
        const unsigned old = xb_add(&bar[XB_XSUB(b.x)], 1u);
        const unsigned gen = old / nloc;
        if (old + 1u == (gen + 1u) * nloc) {
            __builtin_amdgcn_fence(__ATOMIC_RELEASE, "agent");
            asm volatile("s_waitcnt vmcnt(0)" ::: "memory");
            const unsigned og = xb_add(&bar[XB_TOP], 1u);
            const unsigned tg = og / nx;
            if (og + 1u == (tg + 1u) * nx) xb_add(&bar[XB_TOPGEN], 1u);
            else XB_SPIN(xb_ld(&bar[XB_TOPGEN]) == tg, bar);
            __builtin_amdgcn_fence(__ATOMIC_ACQUIRE, "agent");
            xb_add(&bar[XB_XGEN(b.x)], 1u);
            asm volatile("s_waitcnt vmcnt(0)" ::: "memory");
        } else {
            XB_SPIN(xb_ld(&bar[XB_XGEN(b.x)]) == gen, bar);
            __builtin_amdgcn_fence(__ATOMIC_ACQUIRE, "agent");
            asm volatile("s_waitcnt vmcnt(0)" ::: "memory");
        }
    }
    __syncthreads();
}

__device__ __forceinline__ const float* ldarg(const LAS unsigned long long* t, int i) { const unsigned long long v = t[i];
    const unsigned lo = __builtin_amdgcn_readfirstlane((unsigned)v), hi = __builtin_amdgcn_readfirstlane((unsigned)(v >> 32)); return (const float*)(((unsigned long long)hi << 32) | lo); }
constexpr int NPL = 8, NPLX = NPL + 1, NPH = NPLX * DEPTH;
#ifndef USE_CG_SYNC
#define GRID_BAR() xcd_barrier(xbar)
#else
#define GRID_BAR() grid.sync()
#endif
#ifndef PH_MASK
#define PH_MASK 0xffff
#endif
#define PH_EN(k) (((PH_MASK) >> (k)) & 1)
#ifndef ATT_MASK
#define ATT_MASK 15
#endif
#ifndef SD128
#define SD128 2
#endif
#ifndef SD192
#define SD192 1
#endif
#ifndef NQR128
#define NQR128 4
#endif
#ifndef NQR192
#define NQR192 4
#endif
#ifndef ATTV128
#define ATTV128 0
#endif
#ifndef ATTV192
#define ATTV192 0
#endif
#if ATTV128 == 0
#define ATTN128 att::attn_dense_unit<128, NINP, NINP, NINP, DM>
#else
#define ATTN128 att::attn_dense_unit2<128, ATTV128, NINP, NINP, NINP, DM>
#endif
#if ATTV192 == 0
#define ATTN192 att::attn_dense_unit<192, NUQ, NUQ, 768, DM>
#else
#define ATTN192 att::attn_dense_unit2<192, ATTV192, NUQ, NUQ, 768, DM>
#endif
#define ATT_EN(k) (((amask) >> (k)) & 1)

__global__ void __launch_bounds__(NTHR, 2) fwd(Args a) {
    extern __shared__ __attribute__((aligned(16))) unsigned char lds[];
    cg::grid_group grid = cg::this_grid();
    { volatile LAS unsigned long long* at = (volatile LAS unsigned long long*)((LAS unsigned char*)lds + LDS_ARG_OFF);
      if (threadIdx.x == 0) { at[0] = (unsigned long long)a.x; at[1] = (unsigned long long)a.attn_norm; at[2] = (unsigned long long)a.w_in; at[3] = (unsigned long long)a.a_q_norm; at[4] = (unsigned long long)a.a_k_norm;
          at[5] = (unsigned long long)a.c_q_norm; at[6] = (unsigned long long)a.c_kv_norm; at[7] = (unsigned long long)a.w_uq; at[8] = (unsigned long long)a.w_ukv; at[9] = (unsigned long long)a.out_norm;
          at[10] = (unsigned long long)a.w_out; at[11] = (unsigned long long)a.ffn_norm; at[12] = (unsigned long long)a.w_up; at[13] = (unsigned long long)a.conv_w; at[14] = (unsigned long long)a.conv_b;
          at[15] = (unsigned long long)a.w_down; at[16] = (unsigned long long)a.final_norm; at[17] = (unsigned long long)a.out; at[18] = (unsigned long long)a.ws; } }
#define AP(i) ldarg((const LAS unsigned long long*)((LAS unsigned char*)lds + LDS_ARG_OFF), (i))
    const int G = gridDim.x, bx = blockIdx.x;
    const int NGW = G * NWAVES;
#define XN ((bf16*)(ws + WS_XN))
#define X ((bf16*)(ws + WS_X))
#define X2 ((bf16*)(ws + WS_X2))
#define PROJ ((bf16*)(ws + WS_PROJ))
#define QC ((bf16*)(ws + WS_QC))
#define KC ((bf16*)(ws + WS_KC))
#define VC ((bf16*)(ws + WS_VC))
#define OB ((bf16*)(ws + WS_OB))
#define LSE ((float*)(ws + WS_LSE))
#define H ((bf16*)(ws + WS_H))
#define Y ((bf16*)(ws + WS_Y))
#define YN ((bf16*)(ws + WS_YN))
#define ACT ((bf16*)(ws + WS_ACT))

    volatile LAS unsigned* xst = (volatile LAS unsigned*)((LAS unsigned char*)lds + LDS_MISC_OFF);
    if (threadIdx.x < 4) xst[threadIdx.x] = 0u;
    __syncthreads();
    XcdBarrier xbar = xcd_barrier_post((unsigned*)a.ws + CW_BAR, xst);
    if (a.ph_lo < 0) grid.sync();
#ifdef DIAG_A
    if (bx == 0 && threadIdx.x == 0) ((unsigned long long*)ws)[16 + a.ph_lo] = __builtin_amdgcn_s_memrealtime();
#endif
#ifdef REP_PH
    constexpr int REP_LEN = REP_PH2 - REP_PH + 1, REP_X = REP_N * REP_LEN;
    for (int it_ = a.ph_lo; it_ < a.ph_hi + REP_X; ++it_) { const int ph = (it_ <= REP_PH2) ? it_ : ((it_ <= REP_PH2 + REP_X) ? REP_PH + (it_ - REP_PH2 - 1) % REP_LEN : it_ - REP_X);
#else
    for (int ph = a.ph_lo; ph < a.ph_hi; ++ph) {
#endif
        int tid_ = threadIdx.x; asm volatile("" : "+v"(tid_));
#if defined(REP_PH) && defined(REP_ATT_MASK)
        const int amask = (it_ > REP_PH2 && it_ <= REP_PH2 + REP_X) ? (REP_ATT_MASK) : (ATT_MASK);
#else
        const int amask = ATT_MASK;
#endif
        const int tid = tid_, lane = tid & 63, wave = __builtin_amdgcn_readfirstlane(tid >> 6);
        unsigned char* const ws = (unsigned char*)AP(18);
        const int gw = bx * NWAVES + wave;
        const int l = ph / NPLX, k = ph % NPLX - 1;
        unsigned char* wl = ws + WS_W + (size_t)l * WL_SIZE;
        if (k < 0 && PH_EN(12)) {
            float* scr = (float*)(lds + wave * 16384);
            constexpr int I_IN = (DM / 64) * (NIN / 64), I_UQ = (CQR / 64) * (NUQ / 64), I_UKV = (CQR / 64) * (NUKV / 64), I_OUT = (DM / 64) * (DM / 64), I_UP = (DM / 64) * (NUP / 64), I_DN = (DFF / 64) * (DM / 64);
            constexpr int I_L = I_IN + I_UQ + I_UKV;
            for (int it = gw; it < I_L; it += NGW) {
                const int ll = l; int r = it; unsigned char* wb = wl;
                if (r < I_IN) { p0_transpose_item(AP(2) + (size_t)ll * DM * NIN, DM, NIN, (bf16*)(wb + WL_IN), scr, r, lane); continue; } r -= I_IN;
                if (r < I_UQ) { p0_transpose_item(AP(7) + (size_t)ll * CQR * NUQ, CQR, NUQ, (bf16*)(wb + WL_UQ), scr, r, lane, AP(5) + ll * CQR); continue; } r -= I_UQ;
                p0_transpose_item(AP(8) + (size_t)ll * CQR * NUKV, CQR, NUKV, (bf16*)(wb + WL_UKV), scr, r, lane, AP(6) + ll * CQR);
            }
            { unsigned char* wb = wl;
                v4u* z1 = (v4u*)(wb + WL_IN + (size_t)NIN * DM * 2); const int n1 = (NINP - NIN) * DM * 2 / 16;
                for (int i = bx * NTHR + tid; i < n1; i += G * NTHR) z1[i] = (v4u){0u, 0u, 0u, 0u};
                v4u* z2 = (v4u*)(wb + WL_UQ + (size_t)NUQ * CQR * 2); const int n2 = (NUQP - NUQ) * CQR * 2 / 16;
                for (int i = bx * NTHR + tid; i < n2; i += G * NTHR) z2[i] = (v4u){0u, 0u, 0u, 0u};
            }
            if (l == 0) { f32x2* tab = (f32x2*)(ws + WS_TAB);
              for (int i = bx * NTHR + tid; i < TAB_N; i += G * NTHR) {
                  float pos, inv;
                  if (i < TAB_COL) { pos = (float)(i / 32); inv = inv_freq(10000.f, 2 * (i % 32), 64); }
                  else if (i < TAB_PART) { const int q = i - TAB_COL; pos = (float)(q / 32); inv = inv_freq(10000.f, 2 * (q % 32), 64); }
                  else if (i < TAB_MLA) { const int q = i - TAB_PART; pos = (float)(q / 16); inv = inv_freq(500000.f, 2 * (q % 16), 32); }
                  else { const int q = i - TAB_MLA; pos = (float)(q / 32); inv = inv_freq(10000.f, 2 * (q % 32), 64); }
                  const float ang = pos * inv; tab[i] = (f32x2){cosf(ang), sinf(ang)}; } }
            if (l == 0) { int m = gw;
                for (; m + 3 * NGW < T; m += 4 * NGW) rms_rows_bf16<4>(AP(0) + (size_t)m * DM, (size_t)NGW * DM, AP(1), XN + (size_t)m * DM, (size_t)NGW * DM, lane);
                for (; m + NGW < T; m += 2 * NGW) rms_rows_bf16<2>(AP(0) + (size_t)m * DM, (size_t)NGW * DM, AP(1), XN + (size_t)m * DM, (size_t)NGW * DM, lane);
                for (; m < T; m += NGW) rms_rows_bf16<1>(AP(0) + (size_t)m * DM, 0, AP(1), XN + (size_t)m * DM, 0, lane); }
        } else if (k == 0 && PH_EN(0)) {
            pg8::Gemm g{XN, (const pg8::bf16_t*)(wl + WL_IN), T, NINP, DM, DM}; pg8::StaticOrder S; S.init(T, NINP, G, bx);
            pg8::EpiBf16Lat E{PROJ, NINP, (float*)(ws + WS_SSL), CQ_OFF / 256, T};
            pg8::gemm_phase<pg8::EpiBf16Lat, pg8::StaticOrder, true, true>((LAS unsigned char*)lds, g, S, E);
            if (bx >= G / 2) {
                const int sub_w = (bx - G / 2) * NWAVES + wave, sub_n = (G - G / 2) * NWAVES;
                if (l > 0 || G != 256) convert_out(AP(10) + (size_t)l * DM * DM, wl, sub_w, sub_n, lane);
                if (l == 0) convert_up(AP(12), wl, sub_w, sub_n, lane);
                else { convert_down(AP(15) + (size_t)l * DFF * DM, wl, sub_w, sub_n, lane);
                       convert_up(AP(12) + (size_t)l * DM * NUP, wl, sub_w, sub_n, lane, I_UP_SPLIT, I_UP_ALL); }
            }
        } else if (k == 1 && PH_EN(1)) {
            { pg8::Gemm g{PROJ + CQ_OFF, (const pg8::bf16_t*)(wl + WL_UQ), T, NUQP, CQR, NINP}; pg8::StaticOrder S; S.init(T, NUQP, G, bx);
              pg8::EpiBf16Rs<0> E{QC, NUQ, NUQ, nullptr, 0, (const float*)(ws + WS_SSL), 1.f / CQR, EPS};
              pg8::gemm_phase<pg8::EpiBf16Rs<0>, pg8::StaticOrder, true, true>((LAS unsigned char*)lds, g, S, E); }
            { pg8::Gemm g{PROJ + CKV_OFF, (const pg8::bf16_t*)(wl + WL_UKV), T, NUKV, CQR, NINP}; pg8::StaticOrder S; S.init(T, NUKV, G, bx);
              pg8::EpiBf16Rs<1> E{KC, NUQ, 0, VC, 768, (const float*)(ws + WS_SSL) + (size_t)T * 8, 1.f / CQR, EPS};
              pg8::gemm_phase<pg8::EpiBf16Rs<1>, pg8::StaticOrder, true, true>((LAS unsigned char*)lds, g, S, E); }
            { int r0, r1;
              if (G == 256) { if (bx >= 192) { r0 = (bx - 192) * 82; r1 = r0 + 82; } else if (bx >= 160) { r0 = 5248 + (bx - 160) * 46; r1 = r0 + 46; } else { r0 = 6720 + bx * 10; r1 = r0 + 10; }
                              if (r1 > T) r1 = T; if (r0 > T) r0 = T; }
              else { const int per = (T + G - 1) / G; r0 = bx * per; r1 = r0 + per; if (r1 > T) r1 = T; if (r0 > T) r0 = T; }
              for (int m = r0 + wave; m < r1; m += NWAVES) prep_row(PROJ + (size_t)m * NINP, KC + (size_t)m * NUQ, m % SEQ, AP(3) + l * 128, AP(4) + l * 128, AP(5) + l * CQR, AP(6) + l * CQR, (const f32x2*)(ws + WS_TAB), lane); }
            if (l == 0 && G == 256 && bx >= 192) convert_out(AP(10), wl, (bx - 192) * NWAVES + wave, 64 * NWAVES, lane);
        } else if (k == 2 && PH_EN(2)) {
            for (int i_ = 0; i_ < 4; ++i_) {
                int u;
                if (G == 256) {
                    if (bx < 64) { if (i_ >= 2) break; u = 192 + 64 * i_ + bx; }
                    else if (bx < 128) { if (i_ >= 2) break; u = (i_ == 0) ? (bx - 64) : (192 + 128 + (bx - 64)); }
                    else { u = (i_ == 0) ? (64 + (bx - 128)) : (384 + (bx - 128) * 3 + (i_ - 1)); }
                } else { u = bx + i_ * G; if (u >= 768) break; }
                if (u < 192) { if (ATT_EN(0)) { const int b = u / 48, h = (u % 48) / 8, qb = u % 8; const size_t r0 = (size_t)b * SEQ;
                    ATTN192(QC + (r0 + qb * 256) * NUQ + h * 192, KC + r0 * NUQ + h * 192, VC + r0 * 768 + h * 128,
                                              Y + (r0 + qb * 256) * DM + 1280 + h * 128, 0.07216878364870322f, (char*)lds, a.ph_hi > 0 ? SEQ : 0, (const float*)(ws + WS_TAB) + (size_t)2 * (TAB_MLA + qb * 256 * 32));
                } } else if (u < 384) { if (ATT_EN(1)) { const int v = u - 192, b = v / 48, h = (v % 48) / 8, qb = v % 8, kvh = h / 3; const size_t r0 = (size_t)b * SEQ;
                    ATTN128(PROJ + (r0 + qb * 256) * NINP + AQ_OFF + h * 128, PROJ + r0 * NINP + AK_OFF + kvh * 128, PROJ + r0 * NINP + AV_OFF + kvh * 128,
                                              Y + (r0 + qb * 256) * DM + h * 128, 0.088388347648318440f, (char*)lds, a.ph_hi > 0 ? SEQ : 0, nullptr);
                } } else { if (ATT_EN(2)) { const int wu = (u - 384) * 8 + wave;
                    const int g = wu / 1024, rem = wu % 1024, b = rem / 256, h = (rem % 256) / 64, blk = rem % 64;
                    const int dil = (g == 0) ? 1 : (g == 1) ? 4 : 16, L = SEQ / dil, nqb = L / 32, res = blk / nqb, qb = blk % nqb;
                    const size_t row0 = (size_t)b * SEQ + res;
                    att::banded_wave_unit(PROJ + row0 * NINP + BQ_OFF + (g * 4 + h) * 128, (long)dil * NINP, PROJ + row0 * NINP + BK_OFF + h * 128, (long)dil * NINP,
                                          PROJ + row0 * NINP + BV_OFF + h * 128, (long)dil * NINP, qb * 32, L,
                                          OB + ((size_t)g * T + row0) * 512 + h * 128, (long)dil * 512, LSE + ((size_t)g * T + row0) * 4 + h, (long)dil * 4, (char*)lds + wave * 8448);
                } }
            }
        } else if (k == 3 && PH_EN(3)) {
            { int m = gw;
              for (; m + NGW < T; m += 2 * NGW) outnorm_rows<2>(Y + (size_t)m * DM, OB, LSE, m, NGW, AP(9) + l * DM, YN + (size_t)m * DM, lane);
              for (; m < T; m += NGW) outnorm_rows<1>(Y + (size_t)m * DM, OB, LSE, m, 0, AP(9) + l * DM, YN + (size_t)m * DM, lane); }
        } else if (k == 4 && PH_EN(4)) {
            pg8::Gemm g{YN, (const pg8::bf16_t*)(wl + WL_OUT), T, DM, DM, DM}; pg8::StaticOrder S; S.init(T, DM, G, bx);
            float* xb = (float*)(ws + WS_XB) + (size_t)(l * 2) * T * 8; unsigned* nc = (unsigned*)ws + CW_NORM + (l * 2) * 2048;
            if (l == 0) { pg8::EpiResNorm<true> E{AP(0), X, AP(11) + l * DM, XN, nullptr, DM, xb, nc, 1.f / DM, EPS}; pg8::gemm_phase<pg8::EpiResNorm<true>, pg8::StaticOrder, false, true>((LAS unsigned char*)lds, g, S, E); }
            else { pg8::EpiResNorm<false> E{X2, X, AP(11) + l * DM, XN, nullptr, DM, xb, nc, 1.f / DM, EPS}; pg8::gemm_phase<pg8::EpiResNorm<false>, pg8::StaticOrder, false, true>((LAS unsigned char*)lds, g, S, E); }
        } else if (k == 5 && PH_EN(5)) {
            pg8::Gemm g{XN, (const pg8::bf16_t*)(wl + WL_UP), T, NUP, DM, DM}; pg8::StaticOrder S; S.init(T, NUP, G, bx);
            pg8::EpiConvAct E{ACT, (float*)(ws + WS_HB), AP(13) + (size_t)l * 3 * NUP, AP(14) + (size_t)l * NUP, DFF, NUP};
            pg8::gemm_phase<pg8::EpiConvAct, pg8::StaticOrder, true, true>((LAS unsigned char*)lds, g, S, E);
            if (bx >= G / 2) {
                const int sub_w = (bx - G / 2) * NWAVES + wave, sub_n = (G - G / 2) * NWAVES;
                if (l == 0) convert_down(AP(15), wl, sub_w, sub_n, lane);
                if (l + 1 < DEPTH) convert_up(AP(12) + (size_t)(l + 1) * DM * NUP, wl + WL_SIZE, sub_w, sub_n, lane, 0, I_UP_SPLIT);
            }
        } else if (k == 6 && PH_EN(6)) {
            { const float* HBp = (const float*)(ws + WS_HB); const float* cw = AP(13) + (size_t)l * 3 * NUP; const float* cb = AP(14) + (size_t)l * NUP;
              for (int it = bx * NTHR + tid; it < (T / 256) * 2 * (DFF / 8); it += G * NTHR) { const int pm = it / (2 * (DFF / 8)), r2 = it % (2 * (DFF / 8)), bot = r2 / (DFF / 8), c = (r2 % (DFF / 8)) * 8;
                      if ((bot == 0 && (pm % 8) == 0) || (bot == 1 && (pm % 8) == 7)) continue;
                      const int pc = 256 * (c / 128) + (c % 128);
                      const float* rp = bot ? HBp + ((size_t)pm * 4 + 2) * NUP : HBp + ((size_t)(pm - 1) * 4 + 3) * NUP;
                      const float* rc = bot ? HBp + ((size_t)pm * 4 + 3) * NUP : HBp + ((size_t)pm * 4 + 0) * NUP;
                      const float* rn = bot ? HBp + ((size_t)(pm + 1) * 4 + 0) * NUP : HBp + ((size_t)pm * 4 + 1) * NUP;
                      float o[8];
#pragma unroll
                      for (int hq = 0; hq < 2; ++hq) {
                          const f32x4 pg = *(const f32x4*)(rp + pc + 4 * hq), cg = *(const f32x4*)(rc + pc + 4 * hq), ng = *(const f32x4*)(rn + pc + 4 * hq);
                          const f32x4 pu = *(const f32x4*)(rp + pc + 128 + 4 * hq), cu = *(const f32x4*)(rc + pc + 128 + 4 * hq), nu = *(const f32x4*)(rn + pc + 128 + 4 * hq);
                          const f32x4 g0 = *(const f32x4*)(cw + c + 4 * hq), g1 = *(const f32x4*)(cw + NUP + c + 4 * hq), g2 = *(const f32x4*)(cw + 2 * NUP + c + 4 * hq), gb = *(const f32x4*)(cb + c + 4 * hq);
                          const f32x4 u0 = *(const f32x4*)(cw + DFF + c + 4 * hq), u1 = *(const f32x4*)(cw + NUP + DFF + c + 4 * hq), u2 = *(const f32x4*)(cw + 2 * NUP + DFF + c + 4 * hq), ub = *(const f32x4*)(cb + DFF + c + 4 * hq);
#pragma unroll
                          for (int j = 0; j < 4; ++j) { const float gg = gb[j] + g0[j] * pg[j] + g1[j] * cg[j] + g2[j] * ng[j], uv = ub[j] + u0[j] * pu[j] + u1[j] * cu[j] + u2[j] * nu[j];
                              o[4 * hq + j] = gg * __builtin_amdgcn_rcpf(1.f + __builtin_amdgcn_exp2f(-1.4426950408889634f * gg)) * uv; } }
                      v4u w; w.x = pk2(o[0], o[1]); w.y = pk2(o[2], o[3]); w.z = pk2(o[4], o[5]); w.w = pk2(o[6], o[7]);
                      *(v4u*)(ACT + (size_t)(pm * 256 + (bot ? 255 : 0)) * DFF + c) = w; } }
        } else if (k == 7 && PH_EN(7)) {
            pg8::Gemm g{ACT, (const pg8::bf16_t*)(wl + WL_DN), T, DM, DFF, DFF}; pg8::StaticOrder S; S.init(T, DM, G, bx);
            float* xb = (float*)(ws + WS_XB) + (size_t)(l * 2 + 1) * T * 8; unsigned* nc = (unsigned*)ws + CW_NORM + (l * 2 + 1) * 2048;
            if (l + 1 < DEPTH) { pg8::EpiResNorm<false> E{X, X2, AP(1) + (l + 1) * DM, XN, nullptr, DM, xb, nc, 1.f / DM, EPS};
                                 pg8::gemm_phase<pg8::EpiResNorm<false>, pg8::StaticOrder, false, true>((LAS unsigned char*)lds, g, S, E); }
            else { pg8::EpiResNorm<false> E{X, nullptr, AP(16), nullptr, (float*)AP(17), DM, xb, nc, 1.f / DM, EPS};
                   pg8::gemm_phase<pg8::EpiResNorm<false>, pg8::StaticOrder, false, true>((LAS unsigned char*)lds, g, S, E); }
        }
#ifdef EXTRA_SYNCS
        if (ph == 0) for (int e_ = 0; e_ < EXTRA_SYNCS; ++e_) GRID_BAR();
#endif
#ifdef REP_PH
        if (it_ + 1 < a.ph_hi + REP_X) GRID_BAR();
#else
        if (ph + 1 < a.ph_hi) GRID_BAR();
#endif
#ifdef DIAG_A
        if (bx == 0 && threadIdx.x == 0) ((unsigned long long*)ws)[16 + ph + 1] = __builtin_amdgcn_s_memrealtime();
#endif
    }
#ifdef DIAG_A
    grid.sync();
    if (bx == 0) { const unsigned long long* ts = (const unsigned long long*)ws + 16;
        const float dA = (float)(ts[DIAG_A1] - ts[DIAG_A]) * 0.01f, dB = (float)(ts[DIAG_B1] - ts[DIAG_B]) * 0.01f;
        if (threadIdx.x == 0) ((float*)AP(17))[0] += dA;
        for (int i = threadIdx.x; i < 10000; i += NTHR) ((float*)AP(17))[2048 + i] += 0.1f * dB; }
#endif
}
#undef AP
#undef XN
#undef X
#undef X2
#undef PROJ
#undef QC
#undef KC
#undef VC
#undef OB
#undef LSE
#undef H
#undef Y
#undef YN
#undef ACT

#ifndef N_LAUNCH_MODE
#define N_LAUNCH_MODE 1
#endif
extern "C" void kernel_launch(void* const* d_in, const int* in_sizes, int n_in, void* d_out, int out_size, void* d_ws, size_t ws_size, hipStream_t stream) {
    static int grid = 0;
    if (grid == 0) {
        if (n_in != 17 || out_size != T * DM || ws_size < WS_END) { fprintf(stderr, "kernel_launch: unexpected shapes: n_in %d out %d ws %zu (need %zu)\n", n_in, out_size, ws_size, (size_t)WS_END); grid = -1; return; }
        int dev = 0, cus = 0, per_cu = 0;
        if (hipGetDevice(&dev) != hipSuccess || hipDeviceGetAttribute(&cus, hipDeviceAttributeMultiprocessorCount, dev) != hipSuccess) { grid = -1; return; }
        if (hipFuncSetAttribute((const void*)fwd, hipFuncAttributeMaxDynamicSharedMemorySize, LDS_BYTES) != hipSuccess) { fprintf(stderr, "kernel_launch: hipFuncSetAttribute failed\n"); grid = -1; return; }
        if (hipOccupancyMaxActiveBlocksPerMultiprocessor(&per_cu, (const void*)fwd, NTHR, LDS_BYTES) != hipSuccess || per_cu < 1) { fprintf(stderr, "kernel_launch: occupancy query says %d\n", per_cu); (void)hipGetLastError(); }
        grid = cus;
        fprintf(stderr, "kernel_launch: grid %d per_cu %d ws %zu need %zu\n", grid, per_cu, ws_size, (size_t)WS_END);
    }
    if (grid < 0) return;
    if (hipMemsetAsync(d_ws, 0, CTL_ZERO_BYTES, stream) != hipSuccess) { fprintf(stderr, "kernel_launch: memset failed\n"); return; }
    Args a{};
    a.x = (const float*)d_in[0]; a.attn_norm = (const float*)d_in[1]; a.w_in = (const float*)d_in[2]; a.a_q_norm = (const float*)d_in[3]; a.a_k_norm = (const float*)d_in[4];
    a.c_q_norm = (const float*)d_in[5]; a.c_kv_norm = (const float*)d_in[6]; a.w_uq = (const float*)d_in[7]; a.w_ukv = (const float*)d_in[8]; a.out_norm = (const float*)d_in[9];
    a.w_out = (const float*)d_in[10]; a.ffn_norm = (const float*)d_in[11]; a.w_up = (const float*)d_in[12]; a.conv_w = (const float*)d_in[13]; a.conv_b = (const float*)d_in[14];
    a.w_down = (const float*)d_in[15]; a.final_norm = (const float*)d_in[16];
    a.out = (float*)d_out; a.ws = (unsigned char*)d_ws;
#if N_LAUNCH_MODE == 1
    a.ph_lo = 0; a.ph_hi = NPH;
    { void* args[] = {&a}; hipError_t e = hipLaunchCooperativeKernel((void*)fwd, dim3(grid), dim3(NTHR), args, LDS_BYTES, stream);
      if (e != hipSuccess) fprintf(stderr, "kernel_launch: cooperative launch failed: %s\n", hipGetErrorString(e)); }
#else
    for (int ph = 0; ph < NPH; ++ph) { a.ph_lo = ph; a.ph_hi = ph + 1; void* args[] = {&a};
        hipError_t e = hipLaunchCooperativeKernel((void*)fwd, dim3(grid), dim3(NTHR), args, LDS_BYTES, stream);
        if (e != hipSuccess) { fprintf(stderr, "kernel_launch: launch %d failed: %s\n", ph, hipGetErrorString(e)); break; } }
#endif
}
```
